# Optimizing an MI355X kernel written in HIP

```python
import math
import jax
import jax.numpy as jnp
from jax import lax
import numpy as np

D_MODEL = 1024
BATCH = 8
SEQ = 2048
DEPTH = 4
DEC_BATCH = 128
DEC_SEQ = 8
PAST_LEN = 16384
PAGE_SIZE = 128

N_EVEN = (DEPTH + 1) // 2
N_ODD = DEPTH // 2
H_A = 4
DK_A = 128
DV_A = 128
W_A = H_A * DV_A
H_B = 4
W_B = D_MODEL // 2
BLK_B = W_B // H_B
LRU_C = 8.0
CONV_W = 4
D_INNER_C = 2 * D_MODEL
P_C = 64
H_C = D_INNER_C // P_C
N_C = 128
G_C = 4
HPG_C = H_C // G_C
CONV_DIM_C = D_INNER_C + 2 * G_C * N_C
IN_C = D_INNER_C + CONV_DIM_C + H_C
IN_EVEN = 2 * H_A * DK_A + 2 * W_A + 2 * W_B
D_FF = -(-8 * D_MODEL // (3 * 256)) * 256
PLE_DIM = 256
CHUNK = 64
EPS = 1e-6
F32 = jnp.float32

kernel_name = 'hgrn2_rglru_mamba2_hybrid_step'


def _rmsnorm(x, g):
    xf = x.astype(F32)
    y = xf * lax.rsqrt(jnp.mean(xf * xf, axis=-1, keepdims=True) + EPS)
    return (y * g.astype(F32)).astype(x.dtype)


def _chunk_len(L):
    return L if L <= CHUNK else math.gcd(L, CHUNK)


def _to_chunks(t, c):
    B, L = t.shape[:2]
    return jnp.moveaxis(t.reshape((B, L // c, c) + t.shape[2:]), 1, 0)


def _from_chunks(t):
    nc, B, c = t.shape[:3]
    return jnp.moveaxis(t, 0, 1).reshape((B, nc * c) + t.shape[3:])


def _causal_conv(u, buf, w, b):
    L = u.shape[1]
    full = jnp.concatenate([buf.astype(u.dtype), u], axis=1)
    out = full[:, 0:L] * w[0]
    for k in range(1, CONV_W):
        out = out + full[:, k:k + L] * w[k]
    return out + b, full[:, L:]


def _hgrn2_scan(q, logf, k, v, S0):
    c = _chunk_len(q.shape[1])
    causal = jnp.tril(jnp.ones((c, c), dtype=bool))[None, :, :, None, None]

    def step(S, inp):
        qc, lfc, kc, vc = inp
        b = jnp.cumsum(lfc, axis=1)
        o = jnp.einsum('bthd,bhde->bthe', qc * jnp.exp(b), S)
        decay = jnp.exp(jnp.where(causal, b[:, :, None] - b[:, None, :], -jnp.inf))
        scores = jnp.einsum('bthd,bshd,btshd->bhts', qc, kc, decay)
        o = o + jnp.einsum('bhts,bshe->bthe', scores, vc)
        b_last = b[:, -1]
        k_dec = kc * jnp.exp(b_last[:, None] - b)
        S = jnp.exp(b_last)[..., None] * S + jnp.einsum('bshd,bshe->bhde', k_dec, vc)
        return S, o

    S, o = lax.scan(step, S0, (_to_chunks(q, c), _to_chunks(logf, c), _to_chunks(k, c), _to_chunks(v, c)))
    return _from_chunks(o), S


def _ssd_scan(xs, dt, log_a, Bm, Cm, S0):
    c = _chunk_len(xs.shape[1])
    causal = jnp.tril(jnp.ones((c, c), dtype=bool))[None, :, :, None]

    def step(S, inp):
        xc, dtc, lac, Bc, Cc = inp
        Bh = jnp.repeat(Bc, HPG_C, axis=2)
        Ch = jnp.repeat(Cc, HPG_C, axis=2)
        cum = jnp.cumsum(lac, axis=1)
        o = jnp.einsum('bthn,bhpn->bthp', Ch, S) * jnp.exp(cum)[..., None]
        decay = jnp.exp(jnp.where(causal, cum[:, :, None] - cum[:, None, :], -jnp.inf))
        scores = jnp.einsum('bthn,bshn->btsh', Ch, Bh) * decay * dtc[:, None]
        o = o + jnp.einsum('btsh,bshp->bthp', scores, xc)
        last = cum[:, -1]
        w = jnp.exp(last[:, None] - cum) * dtc
        S = jnp.exp(last)[..., None, None] * S + jnp.einsum('bsh,bshp,bshn->bhpn', w, xc, Bh)
        return S, o

    S, o = lax.scan(step, S0, (_to_chunks(xs, c), _to_chunks(dt, c), _to_chunks(log_a, c),
                               _to_chunks(Bm, c), _to_chunks(Cm, c)))
    return _from_chunks(o), S


def _rglru(u, w_a, b_a, w_x, b_x, lam, h0, fresh):
    B, L, _ = u.shape
    ub = u.reshape(B, L, H_B, BLK_B)
    r = jax.nn.sigmoid(jnp.einsum('blhi,hij->blhj', ub, w_a) + b_a).reshape(B, L, W_B)
    gi = jax.nn.sigmoid(jnp.einsum('blhi,hij->blhj', ub, w_x) + b_x).reshape(B, L, W_B)
    log_a = -LRU_C * r * jax.nn.softplus(-lam.astype(F32))
    a = jnp.exp(log_a)
    mult = jnp.sqrt(-jnp.expm1(2.0 * log_a))
    if fresh:
        mult = mult.at[:, 0].set(1.0)
    bt = mult * (gi * u)
    bt = bt.at[:, 0].add(a[:, 0] * h0)

    def combine(lhs, rhs):
        a1, b1 = lhs
        a2, b2 = rhs
        return a1 * a2, a2 * b1 + b2

    _, h = lax.associative_scan(combine, (a, bt), axis=1)
    return h, h[:, -1]


def _even_mixer(xn, S0, h0, cbuf0, fresh, lb, W, j):
    B, L, _ = xn.shape
    hk = H_A * DK_A
    proj = (xn @ W['w_even_in'][j]).astype(F32)
    q, fz, iv, g, yb, ub = jnp.split(
        proj, [hk, 2 * hk, 2 * hk + W_A, 2 * hk + 2 * W_A, 2 * hk + 2 * W_A + W_B], axis=-1)
    lb = lb.reshape(H_A, DK_A)
    fz = fz.reshape(B, L, H_A, DK_A)
    logf = jnp.logaddexp(jnp.log(lb), jnp.log1p(-lb) + jax.nn.log_sigmoid(fz))
    k = (1.0 - lb) * jax.nn.sigmoid(-fz)
    q = jax.nn.silu(q).reshape(B, L, H_A, DK_A)
    o_a, S = _hgrn2_scan(q, logf, k, iv.reshape(B, L, H_A, DV_A), S0.astype(F32))
    o_a = o_a * lax.rsqrt(jnp.mean(o_a * o_a, axis=-1, keepdims=True) + EPS)
    o_a = o_a.reshape(B, L, W_A) * W['hgrn_gnorm'][j].astype(F32) * jax.nn.silu(g)
    u, cbuf = _causal_conv(ub, cbuf0.astype(F32), W['lru_conv_w'][j], W['lru_conv_b'][j])
    h, h_last = _rglru(u, W['lru_wa'][j], W['lru_ba'][j], W['lru_wx'][j], W['lru_bx'][j],
                       W['lru_lam'][j], h0.astype(F32), fresh)
    o_b = jax.nn.gelu(yb, approximate=True) * h
    out = jnp.concatenate([o_a, o_b], axis=-1).astype(xn.dtype) @ W['w_even_out'][j]
    return out, S, h_last, cbuf


def _odd_mixer(xn, S0, cbuf0, W, j):
    B, L, _ = xn.shape
    proj = (xn @ W['ssm_in'][j]).astype(F32)
    z = proj[..., :D_INNER_C]
    xbc = proj[..., D_INNER_C:D_INNER_C + CONV_DIM_C]
    dt = proj[..., D_INNER_C + CONV_DIM_C:]
    xbc, cbuf = _causal_conv(xbc, cbuf0.astype(F32), W['ssm_conv_w'][j], W['ssm_conv_b'][j])
    xbc = jax.nn.silu(xbc)
    xs = xbc[..., :D_INNER_C].reshape(B, L, H_C, P_C)
    Bm = xbc[..., D_INNER_C:D_INNER_C + G_C * N_C].reshape(B, L, G_C, N_C)
    Cm = xbc[..., D_INNER_C + G_C * N_C:].reshape(B, L, G_C, N_C)
    dt = jax.nn.softplus(dt + W['ssm_dt_bias'][j].astype(F32))
    A = -jnp.exp(W['ssm_a_log'][j].astype(F32))
    y, S = _ssd_scan(xs, dt, dt * A, Bm, Cm, S0.astype(F32))
    y = y + W['ssm_d'][j].astype(F32)[:, None] * xs
    y = y.reshape(B, L, D_INNER_C) * jax.nn.silu(z)
    yg = y.reshape(B, L, G_C, D_INNER_C // G_C)
    yg = yg * lax.rsqrt(jnp.mean(yg * yg, axis=-1, keepdims=True) + EPS)
    y = yg.reshape(B, L, D_INNER_C) * W['ssm_gnorm'][j].astype(F32)
    out = y.astype(xn.dtype) @ W['ssm_out'][j]
    return out, S, cbuf


def _swiglu(x, w1, w3, w2):
    return (jax.nn.silu(x @ w1) * (x @ w3)) @ w2


def _ple(x, p_i, w_up, w_gate, g):
    gate = jax.nn.sigmoid((x @ w_gate).astype(F32))
    e = (p_i @ w_up).astype(F32)
    return _rmsnorm(gate * e, g).astype(x.dtype)


def _trunk(x, p, st_hgrn, st_lru_h, st_lru_conv, st_ssm, st_ssm_conv, fresh, W):
    lb_all = jnp.cumsum(jax.nn.softmax(W['hgrn_lb'].astype(F32), axis=0), axis=0)
    lb_all = lb_all - lb_all[0]
    hg, lh, lc, ss, sc = [], [], [], [], []
    for i in range(DEPTH):
        j = i // 2
        xn = _rmsnorm(x, W['g_mix'][i])
        if i % 2 == 0:
            mix, s_a, s_h, s_c = _even_mixer(xn, st_hgrn[j], st_lru_h[j], st_lru_conv[j], fresh, lb_all[j], W, j)
            hg.append(s_a)
            lh.append(s_h)
            lc.append(s_c)
        else:
            mix, s_s, s_c = _odd_mixer(xn, st_ssm[j], st_ssm_conv[j], W, j)
            ss.append(s_s)
            sc.append(s_c)
        x = x + mix
        x = x + _swiglu(_rmsnorm(x, W['g_ffn'][i]), W['ffn_w1'][i], W['ffn_w3'][i], W['ffn_w2'][i])
        x = x + _ple(x, p[i], W['ple_up'][i], W['ple_gate'][i], W['g_ple'][i])
    y = _rmsnorm(x, W['g_final'])
    return (y, jnp.stack(hg).astype(st_hgrn.dtype), jnp.stack(lh).astype(st_lru_h.dtype),
            jnp.stack(lc).astype(st_lru_conv.dtype), jnp.stack(ss).astype(st_ssm.dtype),
            jnp.stack(sc).astype(st_ssm_conv.dtype))


def setup_inputs(seed: int = 0) -> dict:
    key = jax.random.key(seed)
    ks = iter(jax.random.split(key, 64))
    D = D_MODEL

    def nrm(shape, scale):
        return jax.random.normal(next(ks), shape, F32) * scale

    def unif(shape, lo, hi):
        return jax.random.uniform(next(ks), shape, F32, lo, hi)

    a0 = unif((N_EVEN, W_B), 0.9, 0.999) ** (1.0 / LRU_C)
    dt0 = jnp.exp(unif((N_ODD, H_C), math.log(1e-3), math.log(1e-1)))
    inputs = {}
    inputs['x_prompt'] = nrm((BATCH, SEQ, D), 1.0)
    inputs['x_sample'] = nrm((DEC_BATCH, DEC_SEQ, D), 1.0)
    inputs['state_hgrn'] = nrm((N_EVEN, DEC_BATCH, H_A, DK_A, DV_A), 0.5)
    inputs['state_lru_h'] = nrm((N_EVEN, DEC_BATCH, W_B), 0.5)
    inputs['state_lru_conv'] = nrm((N_EVEN, DEC_BATCH, CONV_W - 1, W_B), 1.0)
    inputs['state_ssm'] = nrm((N_ODD, DEC_BATCH, H_C, P_C, N_C), 0.1)
    inputs['state_ssm_conv'] = nrm((N_ODD, DEC_BATCH, CONV_W - 1, CONV_DIM_C), 1.0)
    inputs['p_prompt'] = nrm((DEPTH, BATCH, SEQ, PLE_DIM), 1.0)
    inputs['p_sample'] = nrm((DEPTH, DEC_BATCH, DEC_SEQ, PLE_DIM), 1.0)
    inputs['g_mix'] = 1.0 + nrm((DEPTH, D), 0.05)
    inputs['g_ffn'] = 1.0 + nrm((DEPTH, D), 0.05)
    inputs['g_ple'] = 1.0 + nrm((DEPTH, D), 0.05)
    inputs['g_final'] = 1.0 + nrm((D,), 0.05)
    inputs['w_even_in'] = nrm((N_EVEN, D, IN_EVEN), D ** -0.5)
    inputs['hgrn_lb'] = nrm((N_EVEN, H_A * DK_A), 0.1)
    inputs['hgrn_gnorm'] = 1.0 + nrm((N_EVEN, W_A), 0.05)
    inputs['lru_conv_w'] = nrm((N_EVEN, CONV_W, W_B), CONV_W ** -0.5)
    inputs['lru_conv_b'] = nrm((N_EVEN, W_B), 0.02)
    inputs['lru_wa'] = nrm((N_EVEN, H_B, BLK_B, BLK_B), BLK_B ** -0.5)
    inputs['lru_ba'] = nrm((N_EVEN, H_B, BLK_B), 0.02)
    inputs['lru_wx'] = nrm((N_EVEN, H_B, BLK_B, BLK_B), BLK_B ** -0.5)
    inputs['lru_bx'] = nrm((N_EVEN, H_B, BLK_B), 0.02)
    inputs['lru_lam'] = jnp.log(a0) - jnp.log1p(-a0)
    inputs['w_even_out'] = nrm((N_EVEN, W_A + W_B, D), (W_A + W_B) ** -0.5)
    inputs['ssm_in'] = nrm((N_ODD, D, IN_C), D ** -0.5)
    inputs['ssm_conv_w'] = nrm((N_ODD, CONV_W, CONV_DIM_C), CONV_W ** -0.5)
    inputs['ssm_conv_b'] = nrm((N_ODD, CONV_DIM_C), 0.02)
    inputs['ssm_dt_bias'] = dt0 + jnp.log(-jnp.expm1(-dt0))
    inputs['ssm_a_log'] = jnp.log(unif((N_ODD, H_C), 1.0, 16.0))
    inputs['ssm_d'] = 1.0 + nrm((N_ODD, H_C), 0.1)
    inputs['ssm_gnorm'] = 1.0 + nrm((N_ODD, D_INNER_C), 0.05)
    inputs['ssm_out'] = nrm((N_ODD, D_INNER_C, D), D_INNER_C ** -0.5)
    inputs['ffn_w1'] = nrm((DEPTH, D, D_FF), D ** -0.5)
    inputs['ffn_w3'] = nrm((DEPTH, D, D_FF), D ** -0.5)
    inputs['ffn_w2'] = nrm((DEPTH, D_FF, D), D_FF ** -0.5)
    inputs['ple_up'] = nrm((DEPTH, PLE_DIM, D), PLE_DIM ** -0.5)
    inputs['ple_gate'] = nrm((DEPTH, D, D), D ** -0.5)
    return inputs


def reference(x_prompt, x_sample, state_hgrn, state_lru_h, state_lru_conv, state_ssm, state_ssm_conv,
              p_prompt, p_sample, g_mix, g_ffn, g_ple, g_final, w_even_in, hgrn_lb, hgrn_gnorm,
              lru_conv_w, lru_conv_b, lru_wa, lru_ba, lru_wx, lru_bx, lru_lam, w_even_out,
              ssm_in, ssm_conv_w, ssm_conv_b, ssm_dt_bias, ssm_a_log, ssm_d, ssm_gnorm, ssm_out,
              ffn_w1, ffn_w3, ffn_w2, ple_up, ple_gate):
    W = dict(g_mix=g_mix, g_ffn=g_ffn, g_ple=g_ple, g_final=g_final, w_even_in=w_even_in,
             hgrn_lb=hgrn_lb, hgrn_gnorm=hgrn_gnorm, lru_conv_w=lru_conv_w, lru_conv_b=lru_conv_b,
             lru_wa=lru_wa, lru_ba=lru_ba, lru_wx=lru_wx, lru_bx=lru_bx, lru_lam=lru_lam,
             w_even_out=w_even_out, ssm_in=ssm_in, ssm_conv_w=ssm_conv_w, ssm_conv_b=ssm_conv_b,
             ssm_dt_bias=ssm_dt_bias, ssm_a_log=ssm_a_log, ssm_d=ssm_d, ssm_gnorm=ssm_gnorm,
             ssm_out=ssm_out, ffn_w1=ffn_w1, ffn_w3=ffn_w3, ffn_w2=ffn_w2, ple_up=ple_up,
             ple_gate=ple_gate)
    bp = x_prompt.shape[0]
    dtp = x_prompt.dtype
    z_hgrn = jnp.zeros((N_EVEN, bp, H_A, DK_A, DV_A), dtp)
    z_lru_h = jnp.zeros((N_EVEN, bp, W_B), dtp)
    z_lru_conv = jnp.zeros((N_EVEN, bp, CONV_W - 1, W_B), dtp)
    z_ssm = jnp.zeros((N_ODD, bp, H_C, P_C, N_C), dtp)
    z_ssm_conv = jnp.zeros((N_ODD, bp, CONV_W - 1, CONV_DIM_C), dtp)
    y_prompt, hg_p, lh_p, lc_p, ss_p, sc_p = _trunk(
        x_prompt, p_prompt, z_hgrn, z_lru_h, z_lru_conv, z_ssm, z_ssm_conv, True, W)
    y_sample, hg_s, lh_s, lc_s, ss_s, sc_s = _trunk(
        x_sample, p_sample, state_hgrn, state_lru_h, state_lru_conv, state_ssm, state_ssm_conv, False, W)
    return (y_prompt, y_sample, hg_p, hg_s, lh_p, lh_s, lc_p, lc_s, ss_p, ss_s, sc_p, sc_s)
```

```cpp
#include <hip/hip_runtime.h>
#include <hip/hip_cooperative_groups.h>
#include <cstdio>
#include <cstring>
namespace cg = cooperative_groups;

#define LAS __attribute__((address_space(3)))
typedef unsigned short bf16_t;
typedef short bf16x8 __attribute__((ext_vector_type(8)));
typedef float f32x4 __attribute__((ext_vector_type(4)));
typedef unsigned u32x4 __attribute__((ext_vector_type(4)));
typedef unsigned u32x2 __attribute__((ext_vector_type(2)));

constexpr int NTOK = 17408, NPR = 16384, DM = 1024, NSEQ = 136;
constexpr int KR_OFF = 131072 + 16;
constexpr int LDS_BYTES = 131072 + 16 + 4096;
constexpr float EPSN = 1e-6f;
constexpr int NPH_PER_LAYER = 9, NPHASES = 1 + 4 * NPH_PER_LAYER;

constexpr size_t WO_EIN = 0;
constexpr size_t WO_EOUT = WO_EIN + 2ull * 3072 * 1024;
constexpr size_t WO_SIN = WO_EOUT + 2ull * 1024 * 1024;
constexpr size_t WO_SOUT = WO_SIN + 2ull * 5376 * 1024;
constexpr size_t WO_13 = WO_SOUT + 2ull * 1024 * 2048;
constexpr size_t WO_2 = WO_13 + 4ull * 5632 * 1024;
constexpr size_t WO_G = WO_2 + 4ull * 1024 * 2816;
constexpr size_t WO_U = WO_G + 4ull * 1024 * 1024;
constexpr size_t WO_LRU = WO_U + 4ull * 1024 * 256;
constexpr size_t WO_END = WO_LRU + 2ull * 1024 * 512;

constexpr size_t al(size_t x) { return (x + 4095) & ~(size_t)4095; }
constexpr size_t WS_W = 0;
constexpr size_t WS_X = al(WS_W + WO_END * 2);
constexpr size_t WS_XN = al(WS_X + (size_t)NTOK * 4);
constexpr size_t WS_XB1 = al(WS_XN + (size_t)NTOK * 1024 * 2);
constexpr size_t WS_XB2 = al(WS_XB1 + (size_t)NTOK * 1024 * 2);
constexpr size_t WS_EB = al(WS_XB2 + (size_t)NTOK * 1024 * 2);
constexpr size_t WS_T = al(WS_EB + (size_t)NTOK * 1024 * 2);
constexpr size_t WS_PB = al(WS_T + (size_t)NTOK * 1024 * 2);
constexpr size_t WS_PROJ = al(WS_PB + 4ull * NTOK * 256 * 2);
constexpr size_t WS_U = al(WS_PROJ + (size_t)NTOK * 5376 * 2);
constexpr size_t WS_O = al(WS_U + (size_t)NTOK * 3072 * 2);
constexpr size_t WS_ON = al(WS_O + (size_t)NTOK * 2048 * 2);
constexpr size_t WS_DT = al(WS_ON + (size_t)NTOK * 2048 * 2);
constexpr size_t WS_RSS = al(WS_DT + (size_t)NTOK * 32 * 4 * 2);
constexpr size_t RSS_FLOATS = (size_t)NTOK * 21 + 512;
constexpr size_t RSSN_OFF = (size_t)NTOK * 16, CNT_OFF = (size_t)NTOK * 21;
constexpr size_t WS_HP = al(WS_RSS + RSS_FLOATS * 8);
constexpr size_t HP_UNIT = 4 * 16384 + 1024;
constexpr size_t WS_BAR = al(WS_HP + 1024 * HP_UNIT);
constexpr size_t WS_END = al(WS_BAR + 2 * 3456 * 4);
typedef unsigned long long u64;
constexpr float FXS = 16777216.f, FXI = 1.f / 16777216.f;

constexpr size_t OO_Y = 0;
constexpr size_t OO_HGP = OO_Y + (size_t)NTOK * 1024;
constexpr size_t OO_HGS = OO_HGP + 2ull * 8 * 4 * 128 * 128;
constexpr size_t OO_LHP = OO_HGS + 2ull * 128 * 4 * 128 * 128;
constexpr size_t OO_LHS = OO_LHP + 2ull * 8 * 512;
constexpr size_t OO_LCP = OO_LHS + 2ull * 128 * 512;
constexpr size_t OO_LCS = OO_LCP + 2ull * 8 * 3 * 512;
constexpr size_t OO_SSP = OO_LCS + 2ull * 128 * 3 * 512;
constexpr size_t OO_SSS = OO_SSP + 2ull * 8 * 32 * 64 * 128;
constexpr size_t OO_SCP = OO_SSS + 2ull * 128 * 32 * 64 * 128;
constexpr size_t OO_SCS = OO_SCP + 2ull * 8 * 3 * 3072;
constexpr size_t OO_END = OO_SCS + 2ull * 128 * 3 * 3072;

enum { I_XP = 0, I_XS, I_SHG, I_SLH, I_SLC, I_SSM, I_SSC, I_PP, I_PS, I_GMIX, I_GFFN, I_GPLE, I_GFIN, I_WEIN, I_HLB, I_HGN, I_LCW, I_LCB, I_LWA, I_LBA, I_LWX, I_LBX,
       I_LAM, I_WEOUT, I_SIN, I_SCW, I_SCB, I_SDTB, I_SALOG, I_SD, I_SGN, I_SOUT, I_W1, I_W3, I_W2, I_PUP, I_PGATE, N_IN };

struct Params {
    const float* in[N_IN];
    float* out;
    unsigned char* ws;
    int ph_lo, ph_hi;
};
typedef const Params __attribute__((address_space(4))) KParams;

#define LDSBAR() do { asm volatile("s_waitcnt lgkmcnt(0)" ::: "memory"); __builtin_amdgcn_s_barrier(); asm volatile("" ::: "memory"); } while (0)
__device__ __forceinline__ int tid_opaque() { int t = threadIdx.x; asm volatile("" : "+v"(t)); return t; }
__device__ __forceinline__ int tid_opaque_dep(int dep) { int t = threadIdx.x; asm volatile("" : "+v"(t) : "s"(dep)); return t; }
__device__ __forceinline__ int bid_opaque() { int b = blockIdx.x; asm volatile("" : "+s"(b)); return b; }
__device__ __forceinline__ unsigned cvt_pk_bf16(float lo, float hi) { unsigned r; asm volatile("v_cvt_pk_bf16_f32 %0, %1, %2" : "=v"(r) : "v"(lo), "v"(hi)); return r; }
__device__ __forceinline__ bf16_t f2bf(float f) { unsigned r; asm("v_cvt_pk_bf16_f32 %0, %1, %1" : "=v"(r) : "v"(f)); return (bf16_t)r; }
__device__ __forceinline__ float bf2f(bf16_t h) { return __uint_as_float(((unsigned)h) << 16); }
__device__ __forceinline__ float bflo(unsigned w) { return __uint_as_float(w << 16); }
__device__ __forceinline__ float bfhi(unsigned w) { return __uint_as_float(w & 0xffff0000u); }
__device__ __forceinline__ float sigmoidf_(float x) { return __builtin_amdgcn_rcpf(1.f + __expf(-x)); }
__device__ __forceinline__ float siluf_(float x) { return x * sigmoidf_(x); }
__device__ __forceinline__ float geluf_(float x) { const float u = 0.7978845608028654f * (x + 0.044715f * x * x * x); const float t = 1.f - 2.f * __builtin_amdgcn_rcpf(__expf(2.f * u) + 1.f); return 0.5f * x * (1.f + t); }
__device__ __forceinline__ float softplusf_(float x) { return x > 20.f ? x : log1pf(__expf(x)); }
__device__ __forceinline__ float wave_sum(float v) {
#pragma unroll
    for (int o = 32; o > 0; o >>= 1) v += __shfl_xor(v, o);
    return v;
}


#define XB_TMO      128
#define XB_XCNT(j)  (256  + 64 * (j))
#define XB_XSUB(j)  (1280 + 64 * (j))
#define XB_XGEN(j)  (2304 + 64 * (j))
#define XB_TOP      3328
#define XB_TOPGEN   3392
#define XCD_BAR_WORDS 3456
#define XB_SPIN_CAP (1u << 22)
__device__ __forceinline__ unsigned xb_ld(unsigned* p)              { return __hip_atomic_load(p, __ATOMIC_RELAXED, __HIP_MEMORY_SCOPE_AGENT); }
__device__ __forceinline__ unsigned xb_add(unsigned* p, unsigned v) { return __hip_atomic_fetch_add(p, v, __ATOMIC_RELAXED, __HIP_MEMORY_SCOPE_AGENT); }
__device__ __forceinline__ unsigned xb_xcc_id() { return (unsigned)__builtin_amdgcn_s_getreg((3 << 11) | 20) & 0xFu; }
#define XB_SPIN(cond, bar) do { unsigned _sp = 0; while (cond) { __builtin_amdgcn_s_sleep(1); \
    if ((++_sp & 255u) == 0u) { if (xb_ld(&(bar)[XB_TMO])) break; if (_sp > XB_SPIN_CAP) { atomicAdd(&(bar)[XB_TMO], 1u); break; } } } } while (0)
struct XcdBarrier { unsigned* bar; unsigned x; volatile LAS unsigned* st; unsigned expect; };
__device__ __forceinline__ XcdBarrier xcd_barrier_post(unsigned* bar, volatile LAS unsigned* st, unsigned expect) {
    XcdBarrier b; b.bar = bar; b.x = xb_xcc_id(); b.st = st; b.expect = expect;
    if (threadIdx.x == 0) (void)xb_add(&bar[XB_XCNT(b.x)], 1u);
    return b;
}
__device__ __forceinline__ void xcd_barrier_complete(unsigned* bar, unsigned x, unsigned& nloc, unsigned& nx, unsigned G) {
    unsigned sum, cnt, mine, sp = 0u;
    for (;;) {
        sum = 0u; cnt = 0u; mine = 0u;
#pragma unroll
        for (unsigned j = 0; j < 16; ++j) { const unsigned c = xb_ld(&bar[XB_XCNT(j)]); sum += c; cnt += (c > 0u) ? 1u : 0u; mine = (j == x) ? c : mine; }
        if (sum == G) break;
        __builtin_amdgcn_s_sleep(1);
        if ((++sp & 255u) == 0u) { if (xb_ld(&bar[XB_TMO])) break; if (sp > XB_SPIN_CAP) { atomicAdd(&bar[XB_TMO], 1u); break; } }
    }
    nloc = mine > 0u ? mine : 1u; nx = cnt > 0u ? cnt : 1u;
}
__device__ __forceinline__ void xcd_barrier(const XcdBarrier& b) {
    asm volatile("s_waitcnt vmcnt(0)" ::: "memory");
    __syncthreads();
    if (threadIdx.x == 0) {
        unsigned* bar = b.bar;
        __builtin_amdgcn_s_waitcnt(0);
        unsigned nloc = b.st[0], nx = b.st[1];
        if (nloc == 0u) { xcd_barrier_complete(bar, b.x, nloc, nx, b.expect); b.st[0] = nloc; b.st[1] = nx; }
        const unsigned old = xb_add(&bar[XB_XSUB(b.x)], 1u);
        const unsigned gen = old / nloc;
        if (old + 1u == (gen + 1u) * nloc) {
            __builtin_amdgcn_fence(__ATOMIC_RELEASE, "agent");
            asm volatile("s_waitcnt vmcnt(0)" ::: "memory");
            const unsigned og = xb_add(&bar[XB_TOP], 1u);
            const unsigned tg = og / nx;
            if (og + 1u == (tg + 1u) * nx) xb_add(&bar[XB_TOPGEN], 1u);
            else XB_SPIN(xb_ld(&bar[XB_TOPGEN]) == tg, bar);
            __builtin_amdgcn_fence(__ATOMIC_ACQUIRE, "agent");
            xb_add(&bar[XB_XGEN(b.x)], 1u);
            asm volatile("s_waitcnt vmcnt(0)" ::: "memory");
        } else {
            XB_SPIN(xb_ld(&bar[XB_XGEN(b.x)]) == gen, bar);
            __builtin_amdgcn_fence(__ATOMIC_ACQUIRE, "agent");
            asm volatile("s_waitcnt vmcnt(0)" ::: "memory");
        }
    }
    __syncthreads();
}

namespace pg8 {
constexpr int BM = 256, BK = 64, HALF = 128, HTB = HALF * BK * 2, STAGE_BYTES = 8 * HTB, NXCD = 8, WGM = 8;
__host__ __device__ __forceinline__ int lds_byte(int r, int c) { const int st = (r >> 4) * 2 + (c >> 5), rr = r & 15, cc = c & 31, ob = rr * 64 + cc * 2; return st * 1024 + (ob ^ (((ob >> 9) & 1) << 5)); }
__host__ __device__ __forceinline__ void stage_rc(int b, int& R, int& C) { const int st = b / 1024, sb = b % 1024, swz = sb ^ (((sb >> 9) & 1) << 5); R = (st >> 1) * 16 + swz / 64; C = (st & 1) * 32 + (swz % 64) / 2; }
__host__ __device__ __forceinline__ int perm32(int rho) { const int n = rho >> 4, i = rho & 15; return 8 * (i >> 2) + 4 * n + (i & 3); }
struct Unit { int pm, pn; };
struct Gemm { const bf16_t* A; const bf16_t* Bt; int M, N, K; };
struct StaticOrder {
    int nM, nN, nwg, G, c;
    __device__ void init(int M, int N, int G_, int c_) { nM = M / BM; nN = N / BM; nwg = nM * nN; G = G_; c = c_; }
    __device__ bool next(int i, Unit& u) const {
        const long L = (long)i * G + c; if (L >= nwg) return false;
        int wgid = (int)L; { const int q = nwg / NXCD, r = nwg % NXCD, xcd = wgid % NXCD, off = wgid / NXCD; wgid = (xcd < r ? xcd * (q + 1) : r * (q + 1) + (xcd - r) * q) + off; }
        const int nig = WGM * nN, gid = wgid / nig, fm = gid * WGM, gsz = (nM - fm) < WGM ? (nM - fm) : WGM;
        u.pm = fm + ((wgid % nig) % gsz); u.pn = (wgid % nig) / gsz; return true;
    }
};

template <class Epi>
__device__ __forceinline__ void gemm_phase(LAS unsigned char* lds, const Gemm g, const StaticOrder& S, const Epi& E) {
    const int tid = tid_opaque(), wid = __builtin_amdgcn_readfirstlane(tid >> 6), lane = tid & 63, wr = wid >> 2, wc = wid & 3, fr = lane & 15, fq = lane >> 4;
    const int K = g.K, nt = K / BK;
    unsigned voffA[2], voffB[2];
#pragma unroll
    for (int i = 0; i < 2; ++i) { int R, C; stage_rc(tid * 16 + i * 8192, R, C); const int Rb = Epi::PERM ? ((R & ~31) + perm32(R & 31)) : R;
        voffA[i] = (unsigned)(R * K + C) * 2u; voffB[i] = (unsigned)(Rb * K + C) * 2u; }
    const size_t kstep = (size_t)(BK * 2);
    const size_t hstep = (size_t)HALF * K * 2;
    const size_t tstep = 2 * hstep;
    const unsigned ldsw = (unsigned)wid * 1024u;
    const int aoff = lds_byte(wr * 64 + fr, fq * 8), boff = lds_byte(wc * 32 + fr, fq * 8);
#define PG8_SA(b, h) (((b) * 2 + (h)) * HTB)
#define PG8_SB(b, h) ((4 + (b) * 2 + (h)) * HTB)
#define PG8_STAGE(bufoff, gbase, voff) do { _Pragma("unroll") for (int _i = 0; _i < 2; ++_i) \
        __builtin_amdgcn_global_load_lds((const unsigned*)((const char*)(gbase) + (voff)[_i]), (LAS unsigned*)(lds + (bufoff) + ldsw + _i * 8192), 16, 0, 0); } while (0)
#define PG8_LDA(dst, b, h) do { _Pragma("unroll") for (int m = 0; m < 4; ++m) _Pragma("unroll") for (int k = 0; k < 2; ++k) dst[m][k] = *(const LAS bf16x8*)(lds + PG8_SA(b, h) + aoff + m * 2048 + k * 1024); } while (0)
#define PG8_LDB(dst, b, h) do { _Pragma("unroll") for (int n = 0; n < 2; ++n) _Pragma("unroll") for (int k = 0; k < 2; ++k) dst[n][k] = *(const LAS bf16x8*)(lds + PG8_SB(b, h) + boff + n * 2048 + k * 1024); } while (0)
#define PG8_MMA(ai, bj, At, Bt) do { __builtin_amdgcn_s_setprio(1); _Pragma("unroll") for (int m = 0; m < 4; ++m) _Pragma("unroll") for (int n = 0; n < 2; ++n) _Pragma("unroll") for (int k = 0; k < 2; ++k) \
        acc[ai][bj][m][n] = __builtin_amdgcn_mfma_f32_16x16x32_bf16(Bt[n][k], At[m][k], acc[ai][bj][m][n], 0, 0, 0); __builtin_amdgcn_s_setprio(0); } while (0)
#define PG8_WAIT_V(n) asm volatile("s_waitcnt vmcnt(" #n ")" ::: "memory")
#define PG8_WAIT_L(n) asm volatile("s_waitcnt lgkmcnt(" #n ")" ::: "memory")
#define PG8_BAR __builtin_amdgcn_s_barrier()
#define PG8_SCHED __builtin_amdgcn_sched_barrier(0)
    Unit cur, nxt; int ui = 0;
    if (!S.next(0, cur)) return;
    f32x4 acc[2][2][4][2];
#pragma unroll
    for (int a = 0; a < 2; ++a)
#pragma unroll
        for (int b = 0; b < 2; ++b)
#pragma unroll
            for (int m = 0; m < 4; ++m)
#pragma unroll
                for (int n = 0; n < 2; ++n) acc[a][b][m][n] = (f32x4){0.f, 0.f, 0.f, 0.f};
    bf16x8 At[4][2], B0[2][2], B1[2][2];
    const char* cA = (const char*)g.A + (size_t)cur.pm * tstep; const char* cB = (const char*)g.Bt + (size_t)cur.pn * tstep;
    PG8_STAGE(PG8_SB(0, 0), cB, voffB); PG8_STAGE(PG8_SA(0, 0), cA, voffA); PG8_STAGE(PG8_SB(0, 1), cB + hstep, voffB); PG8_STAGE(PG8_SA(0, 1), cA + hstep, voffA);
    if (wr == 1) PG8_BAR;
    PG8_WAIT_V(4); PG8_BAR;
    PG8_STAGE(PG8_SB(1, 0), cB + kstep, voffB); PG8_STAGE(PG8_SA(1, 0), cA + kstep, voffA); PG8_STAGE(PG8_SB(1, 1), cB + hstep + kstep, voffB);
    PG8_WAIT_V(6); PG8_BAR;
    for (;;) {
        const bool has_next = S.next(ui + 1, nxt);
        const char* nA = has_next ? (const char*)g.A + (size_t)nxt.pm * tstep : cA; const char* nB = has_next ? (const char*)g.Bt + (size_t)nxt.pn * tstep : cB;
        int tseg = nt; if constexpr (Epi::KSCALE) { if (E.kr) tseg = 8; }
        for (int t0 = 0; t0 < nt; t0 += tseg) {
        if (Epi::KSCALE && t0 > 0) {
            const unsigned kaddr = (unsigned)(size_t)lds + (unsigned)KR_OFF + (unsigned)((wr * 64 + fr) * 16 + ((t0 >> 3) - 1) * 4);
#define PG8_KS(a_, m_) do { float rr_; asm volatile("ds_read_b32 %0, %1 offset:%2\n\ts_waitcnt lgkmcnt(0)" : "=v"(rr_) : "v"(kaddr), "n"(((a_) * 128 + (m_) * 16) * 16) : "memory"); \
                acc[a_][0][m_][0] = acc[a_][0][m_][0] * rr_; acc[a_][0][m_][1] = acc[a_][0][m_][1] * rr_; acc[a_][1][m_][0] = acc[a_][1][m_][0] * rr_; acc[a_][1][m_][1] = acc[a_][1][m_][1] * rr_; } while (0)
            PG8_KS(0, 0); PG8_KS(0, 1); PG8_KS(0, 2); PG8_KS(0, 3); PG8_KS(1, 0); PG8_KS(1, 1); PG8_KS(1, 2); PG8_KS(1, 3);
#undef PG8_KS
        }
        for (int t = t0; t < t0 + tseg; t += 2) {
            const bool last = (t == nt - 2);
            const char* a1 = cA + (size_t)(t + 1) * kstep;
            const char* a2 = last ? nA : cA + (size_t)(t + 2) * kstep; const char* b2 = last ? nB : cB + (size_t)(t + 2) * kstep;
            const char* a3 = a2 + kstep; const char* b3 = b2 + kstep;
            PG8_LDB(B0, 0, 0); PG8_SCHED; PG8_LDA(At, 0, 0); PG8_STAGE(PG8_SA(1, 1), a1 + hstep, voffA);
            PG8_WAIT_L(8); PG8_BAR; PG8_WAIT_L(0); PG8_MMA(0, 0, At, B0); PG8_BAR; PG8_SCHED;
            PG8_LDB(B1, 0, 1); PG8_STAGE(PG8_SB(0, 0), b2, voffB);
            PG8_BAR; PG8_WAIT_L(0); PG8_MMA(0, 1, At, B1); PG8_BAR;
            PG8_LDA(At, 0, 1); PG8_STAGE(PG8_SA(0, 0), a2, voffA);
            PG8_BAR; PG8_WAIT_L(0); PG8_MMA(1, 0, At, B0); PG8_BAR; PG8_SCHED;
            PG8_STAGE(PG8_SB(0, 1), b2 + hstep, voffB);
            PG8_WAIT_V(6); PG8_BAR; PG8_MMA(1, 1, At, B1); PG8_BAR;
            PG8_LDB(B0, 1, 0); PG8_SCHED; PG8_LDA(At, 1, 0); PG8_STAGE(PG8_SA(0, 1), a2 + hstep, voffA);
            PG8_WAIT_L(8); PG8_BAR; PG8_WAIT_L(0); PG8_MMA(0, 0, At, B0); PG8_BAR; PG8_SCHED;
            PG8_LDB(B1, 1, 1); PG8_STAGE(PG8_SB(1, 0), b3, voffB);
            PG8_BAR; PG8_WAIT_L(0); PG8_MMA(0, 1, At, B1); PG8_BAR;
            PG8_LDA(At, 1, 1); PG8_STAGE(PG8_SA(1, 0), a3, voffA);
            PG8_BAR; PG8_WAIT_L(0); PG8_MMA(1, 0, At, B0); PG8_BAR; PG8_SCHED;
            PG8_STAGE(PG8_SB(1, 1), b3 + hstep, voffB);
            PG8_WAIT_V(6); PG8_BAR; PG8_MMA(1, 1, At, B1); PG8_BAR;
        }
        }
        if constexpr (!Epi::AFTER_DRAIN) E(acc, cur, wr, wc, fr, fq);
        if (!has_next) break;
#pragma unroll
        for (int a = 0; a < 2; ++a)
#pragma unroll
            for (int b = 0; b < 2; ++b)
#pragma unroll
                for (int m = 0; m < 4; ++m)
#pragma unroll
                    for (int n = 0; n < 2; ++n) acc[a][b][m][n] = (f32x4){0.f, 0.f, 0.f, 0.f};
        cur = nxt; cA = nA; cB = nB; ++ui;
    }
    PG8_WAIT_V(0);
    if (wr == 0) PG8_BAR;
    PG8_BAR;
    if constexpr (Epi::AFTER_DRAIN) E.fused(acc, cur, wr, wc, fr, fq);
#undef PG8_SA
#undef PG8_SB
#undef PG8_STAGE
#undef PG8_LDA
#undef PG8_LDB
#undef PG8_MMA
#undef PG8_WAIT_V
#undef PG8_WAIT_L
#undef PG8_BAR
#undef PG8_SCHED
}
}

struct EpiStore {
    static constexpr bool AFTER_DRAIN = false;
    static constexpr bool KSCALE = false;
    static constexpr bool PERM = true;
    bf16_t* O; int ldc; const u64* rs0;
    __device__ __forceinline__ void operator()(const f32x4 (&acc)[2][2][4][2], const pg8::Unit& u, int wr, int wc, int fr, int fq) const {
        const int row0 = u.pm * 256 + wr * 64 + fr, col0 = u.pn * 256 + wc * 32 + 8 * fq;
#pragma unroll
        for (int ai = 0; ai < 2; ++ai)
#pragma unroll
            for (int m = 0; m < 4; ++m) { bf16_t* rowp = O + (size_t)(row0 + ai * 128 + m * 16) * ldc + col0;
                const float r = rs0 ? rsqrtf((float)rs0[row0 + ai * 128 + m * 16] * (FXI / 1024.f) + EPSN) : 1.f;
#pragma unroll
                for (int bj = 0; bj < 2; ++bj) { const f32x4 v0 = acc[ai][bj][m][0] * r, v1 = acc[ai][bj][m][1] * r;
                    u32x4 w; w[0] = cvt_pk_bf16(v0[0], v0[1]); w[1] = cvt_pk_bf16(v0[2], v0[3]); w[2] = cvt_pk_bf16(v1[0], v1[1]); w[3] = cvt_pk_bf16(v1[2], v1[3]);
                    *(u32x4*)(rowp + bj * 128) = w; } }
    }
};
struct EpiResid {
    static constexpr bool AFTER_DRAIN = false;
    static constexpr bool PERM = true, KSCALE = true;
    bf16_t* XH; u64* rss; const LAS float* kr;
    __device__ __forceinline__ void operator()(const f32x4 (&acc)[2][2][4][2], const pg8::Unit& u, int wr, int wc, int fr, int fq) const {
        const int row0 = u.pm * 256 + wr * 64 + fr, col0 = u.pn * 256 + wc * 32 + 8 * fq;
#pragma unroll
        for (int ai = 0; ai < 2; ++ai)
#pragma unroll
            for (int m = 0; m < 4; ++m) { const int row = row0 + ai * 128 + m * 16; float ss = 0.f;
                const float rl = kr ? kr[(ai * 128 + wr * 64 + m * 16 + fr) * 4 + 3] : 1.f;
#pragma unroll
                for (int bj = 0; bj < 2; ++bj) { bf16_t* xp = XH + (size_t)row * 1024 + col0 + bj * 128; const u32x4 xw = *(const u32x4*)xp; u32x4 w;
#pragma unroll
                    for (int n = 0; n < 2; ++n) { const f32x4 a = acc[ai][bj][m][n] * rl;
                        const float x0 = bflo(xw[2 * n]) + a[0], x1 = bfhi(xw[2 * n]) + a[1], x2 = bflo(xw[2 * n + 1]) + a[2], x3 = bfhi(xw[2 * n + 1]) + a[3];
                        ss += x0 * x0 + x1 * x1 + x2 * x2 + x3 * x3; w[2 * n] = cvt_pk_bf16(x0, x1); w[2 * n + 1] = cvt_pk_bf16(x2, x3); }
                    *(u32x4*)xp = w; }
                if (rss) { ss += __shfl_xor(ss, 16); ss += __shfl_xor(ss, 32); if (fq == 0) atomicAdd(rss + row, (u64)(ss * FXS)); } }
    }
};
struct EpiSwiglu {
    static constexpr bool AFTER_DRAIN = false;
    static constexpr bool KSCALE = false;
    static constexpr bool PERM = true;
    bf16_t* ACT; const u64* rss;
    __device__ __forceinline__ void operator()(const f32x4 (&acc)[2][2][4][2], const pg8::Unit& u, int wr, int wc, int fr, int fq) const {
        const int row0 = u.pm * 256 + wr * 64 + fr, col0 = u.pn * 128 + wc * 32 + 8 * fq;
#pragma unroll
        for (int ai = 0; ai < 2; ++ai)
#pragma unroll
            for (int m = 0; m < 4; ++m) { const int row = row0 + ai * 128 + m * 16;
                const float r = rsqrtf((float)rss[row] * (FXI / 1024.f) + EPSN);
                u32x4 w;
#pragma unroll
                for (int n = 0; n < 2; ++n) { const f32x4 h1 = acc[ai][0][m][n] * r, h3 = acc[ai][1][m][n] * r;
                    w[2 * n] = cvt_pk_bf16(siluf_(h1[0]) * h3[0], siluf_(h1[1]) * h3[1]); w[2 * n + 1] = cvt_pk_bf16(siluf_(h1[2]) * h3[2], siluf_(h1[3]) * h3[3]); }
                *(u32x4*)(ACT + (size_t)row * 2816 + col0) = w; }
    }
};
__device__ __forceinline__ void panel_wait(unsigned* cnt, unsigned need) {
    asm volatile("s_waitcnt vmcnt(0)" ::: "memory");
    __syncthreads();
    if (threadIdx.x == 0) { (void)xb_add(cnt, 1u); unsigned sp = 0u; while (xb_ld(cnt) < need) { __builtin_amdgcn_s_sleep(1); if (++sp > (1u << 22)) break; } }
    __syncthreads();
}
struct EpiPle {
    static constexpr bool KSCALE = false, PERM = true, AFTER_DRAIN = true;
    bf16_t* XH; const bf16_t* EB; u64* rss; u64* rsn; const float* gp; unsigned* cnt;
    __device__ __forceinline__ void fused(f32x4 (&acc)[2][2][4][2], const pg8::Unit& u, int wr, int wc, int fr, int fq) const {
        const int row0 = u.pm * 256 + wr * 64 + fr, col0 = u.pn * 256 + wc * 32 + 8 * fq;
#pragma unroll
        for (int ai = 0; ai < 2; ++ai)
#pragma unroll
            for (int m = 0; m < 4; ++m) { const int row = row0 + ai * 128 + m * 16; float ss = 0.f;
#pragma unroll
                for (int bj = 0; bj < 2; ++bj) { const u32x4 e = *(const u32x4*)(EB + (size_t)row * 1024 + col0 + bj * 128);
#pragma unroll
                    for (int n = 0; n < 2; ++n) { f32x4 v = acc[ai][bj][m][n];
                        v[0] = sigmoidf_(v[0]) * bflo(e[2 * n]); v[1] = sigmoidf_(v[1]) * bfhi(e[2 * n]); v[2] = sigmoidf_(v[2]) * bflo(e[2 * n + 1]); v[3] = sigmoidf_(v[3]) * bfhi(e[2 * n + 1]);
                        ss += v[0] * v[0] + v[1] * v[1] + v[2] * v[2] + v[3] * v[3]; acc[ai][bj][m][n] = v; } }
                ss += __shfl_xor(ss, 16); ss += __shfl_xor(ss, 32); if (fq == 0) atomicAdd(rss + row, (u64)(ss * FXS)); }
        panel_wait(cnt + u.pm, 4u);
#pragma unroll
        for (int ai = 0; ai < 2; ++ai)
#pragma unroll
            for (int m = 0; m < 4; ++m) { const int row = row0 + ai * 128 + m * 16; float ss = 0.f;
                const float rt = rsqrtf((float)__hip_atomic_load(rss + row, __ATOMIC_RELAXED, __HIP_MEMORY_SCOPE_AGENT) * (FXI / 1024.f) + EPSN);
#pragma unroll
                for (int bj = 0; bj < 2; ++bj) { bf16_t* xp = XH + (size_t)row * 1024 + col0 + bj * 128; const u32x4 xw = *(const u32x4*)xp; u32x4 w;
#pragma unroll
                    for (int n = 0; n < 2; ++n) { const f32x4 t = acc[ai][bj][m][n], gg = *(const f32x4*)(gp + col0 + bj * 128 + 4 * n);
                        const float x0 = bflo(xw[2 * n]) + t[0] * rt * gg[0], x1 = bfhi(xw[2 * n]) + t[1] * rt * gg[1], x2 = bflo(xw[2 * n + 1]) + t[2] * rt * gg[2], x3 = bfhi(xw[2 * n + 1]) + t[3] * rt * gg[3];
                        ss += x0 * x0 + x1 * x1 + x2 * x2 + x3 * x3; w[2 * n] = cvt_pk_bf16(x0, x1); w[2 * n + 1] = cvt_pk_bf16(x2, x3); }
                    *(u32x4*)xp = w; }
                ss += __shfl_xor(ss, 16); ss += __shfl_xor(ss, 32); if (fq == 0) atomicAdd(rsn + row, (u64)(ss * FXS)); }
    }
};
struct EpiLru {
    static constexpr bool AFTER_DRAIN = false;
    static constexpr bool KSCALE = false;
    static constexpr bool PERM = false;
    float* LA; float* LBT; const bf16_t* U; const float* ba; const float* bx; const float* lam;
    __device__ __forceinline__ void operator()(const f32x4 (&acc)[2][2][4][2], const pg8::Unit& u, int wr, int wc, int fr, int fq) const {
        const int row0 = u.pm * 256 + wr * 64 + fr, ch0 = u.pn * 128 + wc * 32 + 4 * fq;
#pragma unroll
        for (int n = 0; n < 2; ++n) { const int ch = ch0 + n * 16;
            const f32x4 bav = *(const f32x4*)(ba + ch), bxv = *(const f32x4*)(bx + ch), lmv = *(const f32x4*)(lam + ch);
            f32x4 sp;
#pragma unroll
            for (int q = 0; q < 4; ++q) sp[q] = -8.f * softplusf_(-lmv[q]);
#pragma unroll
            for (int ai = 0; ai < 2; ++ai)
#pragma unroll
                for (int m = 0; m < 4; ++m) { const int row = row0 + ai * 128 + m * 16;
                    const bool first = (row < NPR) && ((row & 2047) == 0);
                    const u32x2 uw = *(const u32x2*)(U + (size_t)row * 512 + ch);
                    const float uu[4] = {bflo(uw[0]), bfhi(uw[0]), bflo(uw[1]), bfhi(uw[1])};
                    f32x4 av, bv;
#pragma unroll
                    for (int q = 0; q < 4; ++q) { const float r = sigmoidf_(acc[ai][0][m][n][q] + bav[q]), gi = sigmoidf_(acc[ai][1][m][n][q] + bxv[q]);
                        const float la = sp[q] * r; av[q] = __expf(la); const float x2 = 2.f * la;
                        const float em = x2 > -0.25f ? -x2 * (1.f + x2 * (0.5f + x2 * (0.16666667f + x2 * (0.041666668f + x2 * 0.0083333338f)))) : 1.f - __expf(x2);
                        const float mult = first ? 1.f : __builtin_amdgcn_sqrtf(em); bv[q] = mult * gi * uu[q]; }
                    *(f32x4*)(LA + (size_t)row * 512 + ch) = av; *(f32x4*)(LBT + (size_t)row * 512 + ch) = bv; }
        }
    }
};


template <class EpiS>
__device__ __forceinline__ void sample_gemm(unsigned char* shm, const bf16_t* A, const bf16_t* Bt, int K, int tile, const EpiS& E, const u64* gss = nullptr) {
    const int tid = tid_opaque(), lane = tid & 63, wid = tid >> 6, fr = lane & 15, fq = lane >> 4, wr = wid >> 2, wc = wid & 3;
    const int tm = tile >> 4, tn = tile & 15;
    constexpr int PIT = 136;
    bf16_t* sA = (bf16_t*)shm; bf16_t* sB = sA + 2 * 64 * PIT;
    const int lrow = tid >> 3, lc8 = (tid & 7) * 8;
    const bf16_t* gA = A + (size_t)(tm * 64 + lrow) * K + lc8;
    const bf16_t* gB = Bt + (size_t)(tn * 64 + lrow) * K + lc8;
    f32x4 acc[2]; acc[0] = (f32x4){0.f, 0.f, 0.f, 0.f}; acc[1] = acc[0];
    u32x4 ra0 = *(const u32x4*)gA, ra1 = *(const u32x4*)(gA + 64), rb0 = *(const u32x4*)gB, rb1 = *(const u32x4*)(gB + 64);
    const int nk = K >> 7;
    LDSBAR();
    for (int kt = 0; kt < nk; ++kt) {
        bf16_t* bA = sA + (kt & 1) * 64 * PIT; bf16_t* bB = sB + (kt & 1) * 64 * PIT;
        *(u32x4*)(bA + lrow * PIT + lc8) = ra0; *(u32x4*)(bA + lrow * PIT + 64 + lc8) = ra1; *(u32x4*)(bB + lrow * PIT + lc8) = rb0; *(u32x4*)(bB + lrow * PIT + 64 + lc8) = rb1;
        LDSBAR();
        if (kt + 1 < nk) { const size_t o = (size_t)(kt + 1) * 128; ra0 = *(const u32x4*)(gA + o); ra1 = *(const u32x4*)(gA + o + 64); rb0 = *(const u32x4*)(gB + o); rb1 = *(const u32x4*)(gB + o + 64); }
        if (gss && kt > 0 && (kt & 3) == 0) { const int gi = (kt >> 2) - 1;
#pragma unroll
            for (int m = 0; m < 2; ++m) { const size_t row = NPR + tm * 64 + wr * 32 + m * 16 + fr;
                const float r0 = rsqrtf((float)gss[(size_t)gi * NTOK + row] * (FXI / 512.f) + EPSN), r1 = rsqrtf((float)gss[(size_t)(gi + 1) * NTOK + row] * (FXI / 512.f) + EPSN);
                acc[m] = acc[m] * (r0 / r1); } }
#pragma unroll
        for (int ks = 0; ks < 4; ++ks) { const bf16x8 bfg = *(const bf16x8*)(bB + (wc * 16 + fr) * PIT + ks * 32 + fq * 8);
#pragma unroll
            for (int m = 0; m < 2; ++m) acc[m] = __builtin_amdgcn_mfma_f32_16x16x32_bf16(bfg, *(const bf16x8*)(bA + (wr * 32 + m * 16 + fr) * PIT + ks * 32 + fq * 8), acc[m], 0, 0, 0); }
    }
    LDSBAR();
    if (gss) {
#pragma unroll
        for (int m = 0; m < 2; ++m) { const size_t row = NPR + tm * 64 + wr * 32 + m * 16 + fr; acc[m] = acc[m] * rsqrtf((float)gss[3 * (size_t)NTOK + row] * (FXI / 512.f) + EPSN); } }
    E(acc, NPR + tm * 64 + wr * 32 + fr, tn * 64 + wc * 16 + 4 * fq, fq);
}
struct EpiSResid {
    bf16_t* XH; u64* rss;
    __device__ __forceinline__ void operator()(const f32x4 (&acc)[2], int row0, int col0, int fq) const {
#pragma unroll
        for (int m = 0; m < 2; ++m) { const int row = row0 + m * 16; bf16_t* xp = XH + (size_t)row * 1024 + col0;
            const u32x2 xw = *(const u32x2*)xp;
            const float x0 = bflo(xw[0]) + acc[m][0], x1 = bfhi(xw[0]) + acc[m][1], x2 = bflo(xw[1]) + acc[m][2], x3 = bfhi(xw[1]) + acc[m][3];
            float ss = x0 * x0 + x1 * x1 + x2 * x2 + x3 * x3;
            u32x2 w; w[0] = cvt_pk_bf16(x0, x1); w[1] = cvt_pk_bf16(x2, x3); *(u32x2*)xp = w;
            if (rss) { ss += __shfl_xor(ss, 16); ss += __shfl_xor(ss, 32); if (fq == 0) atomicAdd(rss + row, (u64)(ss * FXS)); } }
    }
};
struct EpiSPle {
    bf16_t* XH; const bf16_t* EB; u64* rss; u64* rsn; const float* gp; unsigned* cnt;
    __device__ __forceinline__ void operator()(f32x4 (&acc)[2], int row0, int col0, int fq) const {
#pragma unroll
        for (int m = 0; m < 2; ++m) { const int row = row0 + m * 16; const u32x2 e = *(const u32x2*)(EB + (size_t)row * 1024 + col0);
            f32x4 v = acc[m];
            v[0] = sigmoidf_(v[0]) * bflo(e[0]); v[1] = sigmoidf_(v[1]) * bfhi(e[0]); v[2] = sigmoidf_(v[2]) * bflo(e[1]); v[3] = sigmoidf_(v[3]) * bfhi(e[1]);
            float ss = v[0] * v[0] + v[1] * v[1] + v[2] * v[2] + v[3] * v[3]; acc[m] = v;
            ss += __shfl_xor(ss, 16); ss += __shfl_xor(ss, 32); if (fq == 0) atomicAdd(rss + row, (u64)(ss * FXS)); }
        panel_wait(cnt + 64 + ((row0 - NPR) >> 6), 16u);
        const f32x4 gg = *(const f32x4*)(gp + col0);
#pragma unroll
        for (int m = 0; m < 2; ++m) { const int row = row0 + m * 16; bf16_t* xp = XH + (size_t)row * 1024 + col0; const u32x2 xw = *(const u32x2*)xp;
            const float rt = rsqrtf((float)__hip_atomic_load(rss + row, __ATOMIC_RELAXED, __HIP_MEMORY_SCOPE_AGENT) * (FXI / 1024.f) + EPSN);
            const f32x4 t = acc[m];
            const float x0 = bflo(xw[0]) + t[0] * rt * gg[0], x1 = bfhi(xw[0]) + t[1] * rt * gg[1], x2 = bflo(xw[1]) + t[2] * rt * gg[2], x3 = bfhi(xw[1]) + t[3] * rt * gg[3];
            float ss = x0 * x0 + x1 * x1 + x2 * x2 + x3 * x3;
            u32x2 w; w[0] = cvt_pk_bf16(x0, x1); w[1] = cvt_pk_bf16(x2, x3); *(u32x2*)xp = w;
            ss += __shfl_xor(ss, 16); ss += __shfl_xor(ss, 32); if (fq == 0) atomicAdd(rsn + row, (u64)(ss * FXS)); }
    }
};

__device__ __forceinline__ int seq_base(int s) { return s < 8 ? s * 2048 : NPR + (s - 8) * 8; }
__device__ __forceinline__ int seq_len(int s) { return s < 8 ? 2048 : 8; }

template <int LD_SRC, int K, int N, int LD_DST, int ROW_BLK, int ROW_BLK_STRIDE, int ROW_OFF, int NL, int START>
__device__ __forceinline__ void transpose_kind(const float* src0, bf16_t* dst0, size_t dst_stride, float* tile, const float* scale0 = nullptr, int sc_mul = 0, int sc_add = 0) {
    constexpr int NTN = (N + 63) / 64, PER = (K / 64) * NTN, TOT = PER * NL;
    const int tid = tid_opaque(), G = gridDim.x;
    const int first = ((bid_opaque() - START) % G + G) % G;
    f32x4 v[2];
#define TK_FETCH(tt) do { const int l_ = (tt) / PER, lt_ = (tt) % PER, k0_ = (lt_ / NTN) * 64, n0_ = (lt_ % NTN) * 64; const float* src_ = src0 + (size_t)l_ * K * LD_SRC; \
        _Pragma("unroll") for (int i = 0; i < 2; ++i) { const int idx = tid + i * 512, r = idx >> 4, c4 = (idx & 15) * 4; v[i] = (f32x4){0.f, 0.f, 0.f, 0.f}; \
            if (n0_ + c4 < N) v[i] = *(const f32x4*)(src_ + (size_t)(k0_ + r) * LD_SRC + n0_ + c4); } } while (0)
    if (first < TOT) TK_FETCH(first);
    for (int t = first; t < TOT; t += G) {
        const int l = t / PER, lt = t % PER, kt = lt / NTN, ntile = lt % NTN, k0 = kt * 64, n0 = ntile * 64;
        bf16_t* dst = dst0 + (size_t)l * dst_stride;
        LDSBAR();
#pragma unroll
        for (int i = 0; i < 2; ++i) { const int idx = tid + i * 512, r = idx >> 4, c4 = (idx & 15) * 4;
            tile[r * 65 + c4] = v[i][0]; tile[r * 65 + c4 + 1] = v[i][1]; tile[r * 65 + c4 + 2] = v[i][2]; tile[r * 65 + c4 + 3] = v[i][3]; }
        LDSBAR();
        if (t + G < TOT) TK_FETCH(t + G);
#pragma unroll
        for (int i = 0; i < 4; ++i) { const int idx = tid + i * 512, r = idx >> 5, c2 = (idx & 31) * 2, n = n0 + r;
            if (n < N) { const int drow = (n / ROW_BLK) * ROW_BLK_STRIDE + (n % ROW_BLK) + ROW_OFF;
                float sa = 1.f, sb = 1.f; if (scale0) { const float* sc = scale0 + (size_t)(l * sc_mul + sc_add) * 1024 + k0 + c2; sa = sc[0]; sb = sc[1]; }
                *(unsigned*)(dst + (size_t)drow * LD_DST + k0 + c2) = cvt_pk_bf16(tile[c2 * 65 + r] * sa, tile[(c2 + 1) * 65 + r] * sb); } }
    }
#undef TK_FETCH
    LDSBAR();
}
__device__ void phase_init(KParams& p, unsigned char* shm) {
    const int tid = tid_opaque(), G = gridDim.x, bid = bid_opaque();
    float* tile = (float*)shm;
    {
        bf16_t* Wt = (bf16_t*)(p.ws + WS_W);
        constexpr int T0 = 0, T1 = T0 + 2 * 16 * 48, T2 = T1 + 2 * 16 * 16, T3 = T2 + 2 * 16 * 81, T4 = T3 + 2 * 32 * 16, T5 = T4 + 4 * 16 * 44, T6 = T5 + 4 * 16 * 44, T7 = T6 + 4 * 44 * 16, T8 = T7 + 4 * 16 * 16;
        transpose_kind<3072, 1024, 3072, 1024, 3072, 3072, 0, 2, T0>(p.in[I_WEIN], Wt + WO_EIN, 3072ull * 1024, tile, p.in[I_GMIX], 2, 0);
        transpose_kind<1024, 1024, 1024, 1024, 1024, 1024, 0, 2, T1>(p.in[I_WEOUT], Wt + WO_EOUT, 1024ull * 1024, tile);
        transpose_kind<5152, 1024, 5152, 1024, 5152, 5152, 0, 2, T2>(p.in[I_SIN], Wt + WO_SIN, 5376ull * 1024, tile, p.in[I_GMIX], 2, 1);
        transpose_kind<1024, 2048, 1024, 2048, 1024, 1024, 0, 2, T3>(p.in[I_SOUT], Wt + WO_SOUT, 1024ull * 2048, tile, p.in[I_SGN], 2, 0);
        transpose_kind<2816, 1024, 2816, 1024, 128, 256, 0, 4, T4>(p.in[I_W1], Wt + WO_13, 5632ull * 1024, tile, p.in[I_GFFN], 1, 0);
        transpose_kind<2816, 1024, 2816, 1024, 128, 256, 128, 4, T5>(p.in[I_W3], Wt + WO_13, 5632ull * 1024, tile, p.in[I_GFFN], 1, 0);
        transpose_kind<1024, 2816, 1024, 2816, 1024, 1024, 0, 4, T6>(p.in[I_W2], Wt + WO_2, 1024ull * 2816, tile);
        transpose_kind<1024, 1024, 1024, 1024, 1024, 1024, 0, 4, T7>(p.in[I_PGATE], Wt + WO_G, 1024ull * 1024, tile);
        transpose_kind<1024, 256, 1024, 256, 1024, 1024, 0, 4, T8>(p.in[I_PUP], Wt + WO_U, 1024ull * 256, tile);
    }
    bf16_t* W = (bf16_t*)(p.ws + WS_W);
    for (int idx0 = bid * 512 + tid; idx0 < 2 * 1024 * 512; idx0 += 4 * G * 512) { float vv[4];
#pragma unroll
        for (int q = 0; q < 4; ++q) { const int idx = idx0 + q * G * 512; vv[q] = 0.f;
            if (idx < 2 * 1024 * 512) { const int k = idx & 511, n = (idx >> 9) & 1023, j = idx >> 19, hb = n >> 8, gate = (n >> 7) & 1, c = n & 127;
                if ((k >> 7) == hb) { const float* gw = gate ? p.in[I_LWX] : p.in[I_LWA]; vv[q] = gw[(((size_t)j * 4 + hb) * 128 + (k & 127)) * 128 + c]; } } }
#pragma unroll
        for (int q = 0; q < 4; ++q) { const int idx = idx0 + q * G * 512; if (idx < 2 * 1024 * 512) W[WO_LRU + idx] = f2bf(vv[q]); }
    }
    u64* RSN0 = (u64*)(p.ws + WS_RSS) + RSSN_OFF; bf16_t* XH = (bf16_t*)(p.ws + WS_XN);
    const int wid = tid >> 6, lane = tid & 63;
    for (int row0 = bid * 8 + wid; row0 < NTOK; row0 += 2 * G * 8) { f32x4 xv[2][4];
#pragma unroll
        for (int k = 0; k < 2; ++k) { const int row = row0 + k * G * 8;
#pragma unroll
            for (int i = 0; i < 4; ++i) xv[k][i] = (f32x4){0.f, 0.f, 0.f, 0.f};
            if (row < NTOK) { const float* src = row < NPR ? p.in[I_XP] + (size_t)row * 1024 : p.in[I_XS] + (size_t)(row - NPR) * 1024;
#pragma unroll
                for (int i = 0; i < 4; ++i) xv[k][i] = *(const f32x4*)(src + i * 256 + lane * 4); } }
#pragma unroll
        for (int k = 0; k < 2; ++k) { const int row = row0 + k * G * 8;
            if (row < NTOK) { float ss = 0.f;
#pragma unroll
                for (int i = 0; i < 4; ++i) { const int c = i * 256 + lane * 4; const f32x4 v = xv[k][i]; ss += v[0] * v[0] + v[1] * v[1] + v[2] * v[2] + v[3] * v[3];
                    u32x2 w; w[0] = cvt_pk_bf16(v[0], v[1]); w[1] = cvt_pk_bf16(v[2], v[3]); *(u32x2*)(XH + (size_t)row * 1024 + c) = w; }
                ss = wave_sum(ss); if (lane == 0) RSN0[row] = (u64)(ss * FXS); } }
    }
    bf16_t* PB = (bf16_t*)(p.ws + WS_PB);
    { const size_t total = 4ull * NTOK * 64, stride = (size_t)G * 512;
      for (size_t idx0 = (size_t)bid * 512 + tid; idx0 < total; idx0 += 4 * stride) { f32x4 v[4];
#pragma unroll
        for (int k = 0; k < 4; ++k) { const size_t idx = idx0 + k * stride; v[k] = (f32x4){0.f, 0.f, 0.f, 0.f};
            if (idx < total) { const int c4 = (int)(idx & 63); const size_t rt = idx >> 6; const int tok = (int)(rt % NTOK), l = (int)(rt / NTOK);
                const float* src = tok < NPR ? p.in[I_PP] + ((size_t)l * NPR + tok) * 256 : p.in[I_PS] + ((size_t)l * 1024 + (tok - NPR)) * 256;
                v[k] = *(const f32x4*)(src + c4 * 4); } }
#pragma unroll
        for (int k = 0; k < 4; ++k) { const size_t idx = idx0 + k * stride;
            if (idx < total) { u32x2 w; w[0] = cvt_pk_bf16(v[k][0], v[k][1]); w[1] = cvt_pk_bf16(v[k][2], v[k][3]); *(u32x2*)(PB + (idx >> 6) * 256 + (idx & 63) * 4) = w; } } } }
    u64* RSS = (u64*)(p.ws + WS_RSS);
    for (size_t idx = (size_t)bid * 512 + tid; idx < RSS_FLOATS; idx += (size_t)G * 512) if (idx < RSSN_OFF || idx >= RSSN_OFF + NTOK) RSS[idx] = 0ull;
}

__device__ void phase_conv_lru(KParams& p, int j) {
    const bf16_t* PROJ = (const bf16_t*)(p.ws + WS_PROJ); bf16_t* U = (bf16_t*)(p.ws + WS_U);
    const float* cw = p.in[I_LCW] + (size_t)j * 4 * 512; const float* cb = p.in[I_LCB] + (size_t)j * 512;
    for (int idx = bid_opaque() * 512 + tid_opaque(); idx < NTOK * 64; idx += gridDim.x * 512) {
        const int row = idx >> 6, c8 = (idx & 63) * 8;
        int t, L, b; const bool pr = row < NPR;
        if (pr) { t = row & 2047; L = 2048; b = row >> 11; } else { t = (row - NPR) & 7; L = 8; b = (row - NPR) >> 3; }
        float o[8];
#pragma unroll
        for (int q = 0; q < 8; ++q) o[q] = cb[c8 + q];
        float last[8];
#pragma unroll
        for (int k = 0; k < 4; ++k) { const int m = t + k; float v[8];
            if (m >= 3) { const u32x4 w = *(const u32x4*)(PROJ + (size_t)(row + k - 3) * 3072 + 2560 + c8);
#pragma unroll
                for (int q = 0; q < 4; ++q) { v[2 * q] = bflo(w[q]); v[2 * q + 1] = bfhi(w[q]); } }
            else if (!pr) { const float* sp = p.in[I_SLC] + (((size_t)j * 128 + b) * 3 + m) * 512 + c8;
#pragma unroll
                for (int q = 0; q < 8; ++q) v[q] = sp[q]; }
            else {
#pragma unroll
                for (int q = 0; q < 8; ++q) v[q] = 0.f; }
#pragma unroll
            for (int q = 0; q < 8; ++q) { o[q] += cw[k * 512 + c8 + q] * v[q]; if (k == 3) last[q] = v[q]; } }
        u32x4 w;
#pragma unroll
        for (int q = 0; q < 4; ++q) w[q] = cvt_pk_bf16(o[2 * q], o[2 * q + 1]);
        *(u32x4*)(U + (size_t)row * 512 + c8) = w;
        if (t >= L - 3) { const int r = t - (L - 3);
            float* dst = pr ? p.out + OO_LCP + (((size_t)j * 8 + b) * 3 + r) * 512 + c8 : p.out + OO_LCS + (((size_t)j * 128 + b) * 3 + r) * 512 + c8;
#pragma unroll
            for (int q = 0; q < 8; ++q) dst[q] = last[q]; }
    }
}

__device__ void hgrn_unit(KParams& p, int j, int s, int h, unsigned char* shm) {
    const int tid = tid_opaque(), dv = tid & 127, dq = tid >> 7, wid = tid >> 6, lane = tid & 63;
    const bf16_t* PROJ = (const bf16_t*)(p.ws + WS_PROJ); bf16_t* O = (bf16_t*)(p.ws + WS_O);
    float* qs = (float*)shm; float* fs = qs + 16 * 128; float* ks = fs + 16 * 128; float* vs = ks + 16 * 128; float* op = vs + 16 * 128;
    const int base = seq_base(s), L = seq_len(s), nb = L < 16 ? L : 16;
    float S[32];
    if (s >= 8) { const float* s0 = p.in[I_SHG] + (((size_t)j * 128 + (s - 8)) * 4 + h) * 16384;
#pragma unroll
        for (int i = 0; i < 32; ++i) S[i] = s0[(dq * 32 + i) * 128 + dv]; }
    else {
#pragma unroll
        for (int i = 0; i < 32; ++i) S[i] = 0.f; }
    const float gn0 = p.in[I_HGN][j * 512 + h * 128 + lane], gn1 = p.in[I_HGN][j * 512 + h * 128 + lane + 64];
    for (int t0 = 0; t0 < L; t0 += nb) {
        LDSBAR();
        for (int idx = tid; idx < nb * 128; idx += 512) { const int t = idx >> 7, dk = idx & 127; const size_t ro = (size_t)(base + t0 + t) * 3072 + h * 128 + dk;
            const float q = bf2f(PROJ[ro]), fz = bf2f(PROJ[ro + 512]);
            float lb = 0.f;
            if (j == 1) lb = sigmoidf_(p.in[I_HLB][512 + h * 128 + dk] - p.in[I_HLB][h * 128 + dk]);
            const float sg = sigmoidf_(fz);
            qs[idx] = siluf_(q); fs[idx] = lb + (1.f - lb) * sg; ks[idx] = (1.f - lb) * (1.f - sg); vs[idx] = bf2f(PROJ[ro + 1024]); }
        LDSBAR();
#pragma unroll 2
        for (int t = 0; t < nb; ++t) { float o = 0.f; const float vt = vs[t * 128 + dv];
#pragma unroll
            for (int i4 = 0; i4 < 8; ++i4) { const f32x4 f4 = *(const f32x4*)(fs + t * 128 + dq * 32 + i4 * 4), k4 = *(const f32x4*)(ks + t * 128 + dq * 32 + i4 * 4), q4 = *(const f32x4*)(qs + t * 128 + dq * 32 + i4 * 4);
#pragma unroll
                for (int e = 0; e < 4; ++e) { const int i = i4 * 4 + e; S[i] = f4[e] * S[i] + k4[e] * vt; o += q4[e] * S[i]; } }
            op[(t * 4 + dq) * 128 + dv] = o; }
        LDSBAR();
        for (int t = wid; t < nb; t += 8) { const int row = base + t0 + t;
            const float o0 = op[(t * 4 + 0) * 128 + lane] + op[(t * 4 + 1) * 128 + lane] + op[(t * 4 + 2) * 128 + lane] + op[(t * 4 + 3) * 128 + lane];
            const float o1 = op[(t * 4 + 0) * 128 + lane + 64] + op[(t * 4 + 1) * 128 + lane + 64] + op[(t * 4 + 2) * 128 + lane + 64] + op[(t * 4 + 3) * 128 + lane + 64];
            const float ss = wave_sum(o0 * o0 + o1 * o1), r = rsqrtf(ss * (1.f / 128.f) + EPSN);
            const float g0 = bf2f(PROJ[(size_t)row * 3072 + 1536 + h * 128 + lane]), g1 = bf2f(PROJ[(size_t)row * 3072 + 1536 + h * 128 + lane + 64]);
            O[(size_t)row * 1024 + h * 128 + lane] = f2bf(o0 * r * gn0 * siluf_(g0)); O[(size_t)row * 1024 + h * 128 + lane + 64] = f2bf(o1 * r * gn1 * siluf_(g1)); }
    }
    float* so = s < 8 ? p.out + OO_HGP + (((size_t)j * 8 + s) * 4 + h) * 16384 : p.out + OO_HGS + (((size_t)j * 128 + (s - 8)) * 4 + h) * 16384;
#pragma unroll
    for (int i = 0; i < 32; ++i) so[(dq * 32 + i) * 128 + dv] = S[i];
}


__device__ __forceinline__ f32x4 mfma16(bf16x8 a, bf16x8 b, f32x4 c) { return __builtin_amdgcn_mfma_f32_16x16x32_bf16(a, b, c, 0, 0, 0); }
__device__ void hgrn_prep_unit(KParams& p, int j, int u, unsigned char* shm) {
    const int tid = tid_opaque(), dk = tid & 127, seg = tid >> 7, lane = tid & 63, wid = tid >> 6, fr = lane & 15, fq = lane >> 4;
    const int c = u & 31, h = (u >> 5) & 3, b = u >> 7;
    const bf16_t* PROJ = (const bf16_t*)(p.ws + WS_PROJ);
    unsigned char* hp = p.ws + WS_HP + (size_t)u * HP_UNIT;
    bf16_t* gqe = (bf16_t*)hp; bf16_t* gpp = gqe + 8192; bf16_t* gkdt = gpp + 8192; bf16_t* gvt = gkdt + 8192; float* gbr = (float*)(hp + 65536); float* gbt = gbr + 128;
    bf16_t* lqe = (bf16_t*)shm; bf16_t* lke = (bf16_t*)(shm + 17408); float* segs = (float*)(shm + 40960);
    float lbv = 0.f;
    if (j == 1) lbv = sigmoidf_(p.in[I_HLB][512 + h * 128 + dk] - p.in[I_HLB][h * 128 + dk]);
    const size_t r0 = (size_t)b * 2048 + c * 64;
    float qq[16], kk[16], bl[16]; float run = 0.f;
#pragma unroll
    for (int i = 0; i < 16; ++i) { const size_t ro = (r0 + seg * 16 + i) * 3072 + h * 128 + dk;
        const float q = bf2f(PROJ[ro]), fz = bf2f(PROJ[ro + 512]); const float sg = sigmoidf_(fz);
        const float f = lbv + (1.f - lbv) * sg; kk[i] = (1.f - lbv) * (1.f - sg); qq[i] = siluf_(q); run += __logf(f); bl[i] = run; }
    unsigned vw[8];
#pragma unroll
    for (int i = 0; i < 8; ++i) { const size_t ro = (r0 + seg * 16 + 2 * i) * 3072 + 1024 + h * 128 + dk; vw[i] = (unsigned)PROJ[ro] | ((unsigned)PROJ[ro + 3072] << 16); }
    __syncthreads();
    segs[seg * 128 + dk] = run;
    __syncthreads();
    const float s0 = segs[dk], s1 = segs[128 + dk], s2 = segs[256 + dk], s3 = segs[384 + dk];
    const float bref = s0 + s1, tot = bref + s2 + s3, off = seg == 0 ? 0.f : (seg == 1 ? s0 : (seg == 2 ? bref : bref + s2));
    unsigned kdw[8];
#pragma unroll
    for (int i = 0; i < 16; ++i) { const float bb = off + bl[i]; const int t = seg * 16 + i;
        const bf16_t qv = f2bf(qq[i] * __expf(bb - bref)); gqe[t * 128 + dk] = qv; lqe[t * 136 + dk] = qv; lke[t * 136 + dk] = f2bf(kk[i] * __expf(bref - bb));
        const unsigned kd = f2bf(kk[i] * __expf(tot - bb)); if (i & 1) kdw[i >> 1] |= kd << 16; else kdw[i >> 1] = kd; }
    u32x4 w0, w1; w0[0] = kdw[0]; w0[1] = kdw[1]; w0[2] = kdw[2]; w0[3] = kdw[3]; w1[0] = kdw[4]; w1[1] = kdw[5]; w1[2] = kdw[6]; w1[3] = kdw[7];
    *(u32x4*)(gkdt + dk * 64 + seg * 16) = w0; *(u32x4*)(gkdt + dk * 64 + seg * 16 + 8) = w1;
    w0[0] = vw[0]; w0[1] = vw[1]; w0[2] = vw[2]; w0[3] = vw[3]; w1[0] = vw[4]; w1[1] = vw[5]; w1[2] = vw[6]; w1[3] = vw[7];
    *(u32x4*)(gvt + dk * 64 + seg * 16) = w0; *(u32x4*)(gvt + dk * 64 + seg * 16 + 8) = w1;
    if (seg == 0) { gbr[dk] = bref; gbt[dk] = tot; }
    __syncthreads();
    {
        const int ti = wid >> 1, si0 = (wid & 1) * 2;
#pragma unroll
        for (int q = 0; q < 2; ++q) { const int si = si0 + q; f32x4 a = (f32x4){0.f, 0.f, 0.f, 0.f};
            if (si <= ti) {
#pragma unroll
                for (int k4 = 0; k4 < 4; ++k4) a = mfma16(*(const bf16x8*)(lqe + (ti * 16 + fr) * 136 + k4 * 32 + fq * 8), *(const bf16x8*)(lke + (si * 16 + fr) * 136 + k4 * 32 + fq * 8), a); }
#pragma unroll
            for (int jj = 0; jj < 4; ++jj) { const int t = ti * 16 + fq * 4 + jj, sx = si * 16 + fr; gpp[t * 64 + sx] = f2bf(sx <= t ? a[jj] : 0.f); } }
    }
}
__device__ void hgrn_prompt_unit(KParams& p, int j, int b, int h, unsigned char* shm) {
    const int tid = tid_opaque(), lane = tid & 63, wid = tid >> 6, fr = lane & 15, fq = lane >> 4;
    const bf16_t* PROJ = (const bf16_t*)(p.ws + WS_PROJ); bf16_t* O = (bf16_t*)(p.ws + WS_O);
    constexpr int QE = 0, KE = 17408, KDT = 34816, VT = 53248, PP = 71680, STS = 80896;
    bf16_t* qe = (bf16_t*)(shm + QE); bf16_t* ke = (bf16_t*)(shm + KE); bf16_t* kdt = (bf16_t*)(shm + KDT); bf16_t* vt = (bf16_t*)(shm + VT);
    bf16_t* pp = (bf16_t*)(shm + PP); bf16_t* sts = (bf16_t*)(shm + STS); float* ob = (float*)(shm + KDT);
    const unsigned char* hp0 = p.ws + WS_HP + (size_t)((b * 4 + h) * 32) * HP_UNIT;
    f32x4 Sacc[8];
#pragma unroll
    for (int i = 0; i < 8; ++i) Sacc[i] = (f32x4){0.f, 0.f, 0.f, 0.f};
    u32x4 rq[2], rp, rd[2], rv[2]; float brv[8], btv[8];
#define HG_FETCH(cc) do { const unsigned char* hp = hp0 + (size_t)(cc) * HP_UNIT; \
        _Pragma("unroll") for (int q = 0; q < 2; ++q) { const int ch = tid + q * 512; rq[q] = *(const u32x4*)(hp + ch * 16); rd[q] = *(const u32x4*)(hp + 32768 + ch * 16); rv[q] = *(const u32x4*)(hp + 49152 + ch * 16); } \
        rp = *(const u32x4*)(hp + 16384 + tid * 16); \
        _Pragma("unroll") for (int td = 0; td < 8; ++td) { brv[td] = ((const float*)(hp + 65536))[td * 16 + fr]; btv[td] = ((const float*)(hp + 65536))[128 + td * 16 + fr]; } } while (0)
    float gnv[16];
    { const float* gn = p.in[I_HGN] + j * 512 + h * 128 + (tid & 7) * 16;
#pragma unroll
      for (int q = 0; q < 16; ++q) gnv[q] = gn[q]; }
    HG_FETCH(0);
    for (int c = 0; c < 32; ++c) {
        const size_t r0 = (size_t)b * 2048 + c * 64;
        LDSBAR();
        float dec[8];
#pragma unroll
        for (int q = 0; q < 2; ++q) { const int ch = tid + q * 512;
            *(u32x4*)(qe + (ch >> 4) * 136 + (ch & 15) * 8) = rq[q];
            *(u32x4*)(kdt + (ch >> 3) * 72 + (ch & 7) * 8) = rd[q]; *(u32x4*)(vt + (ch >> 3) * 72 + (ch & 7) * 8) = rv[q]; }
        *(u32x4*)(pp + (tid >> 3) * 72 + (tid & 7) * 8) = rp;
#pragma unroll
        for (int td = 0; td < 8; ++td) { const float sc = __expf(brv[td]); dec[td] = __expf(btv[td]);
#pragma unroll
            for (int jj = 0; jj < 4; ++jj) sts[(wid * 16 + fq * 4 + jj) * 136 + td * 16 + fr] = f2bf(Sacc[td][jj] * sc); }
        if (c + 1 < 32) HG_FETCH(c + 1);
        const int et = tid >> 3, part = tid & 7; const size_t erow = r0 + et;
        const u32x4 g0 = *(const u32x4*)(PROJ + erow * 3072 + 1536 + h * 128 + part * 16), g1 = *(const u32x4*)(PROJ + erow * 3072 + 1536 + h * 128 + part * 16 + 8);
        LDSBAR();
        f32x4 oacc[4];
        {
            const int ti = wid & 3, dv0 = (wid >> 2) * 4;
#pragma unroll
            for (int d = 0; d < 4; ++d) oacc[d] = (f32x4){0.f, 0.f, 0.f, 0.f};
#pragma unroll
            for (int k4 = 0; k4 < 4; ++k4) { const bf16x8 a = *(const bf16x8*)(qe + (ti * 16 + fr) * 136 + k4 * 32 + fq * 8);
#pragma unroll
                for (int d = 0; d < 4; ++d) oacc[d] = mfma16(a, *(const bf16x8*)(sts + ((dv0 + d) * 16 + fr) * 136 + k4 * 32 + fq * 8), oacc[d]); }
#pragma unroll
            for (int k2 = 0; k2 < 2; ++k2) { const bf16x8 a = *(const bf16x8*)(pp + (ti * 16 + fr) * 72 + k2 * 32 + fq * 8);
#pragma unroll
                for (int d = 0; d < 4; ++d) oacc[d] = mfma16(a, *(const bf16x8*)(vt + ((dv0 + d) * 16 + fr) * 72 + k2 * 32 + fq * 8), oacc[d]); }
            const bf16x8 v0 = *(const bf16x8*)(vt + (wid * 16 + fr) * 72 + fq * 8), v1 = *(const bf16x8*)(vt + (wid * 16 + fr) * 72 + 32 + fq * 8);
#pragma unroll
            for (int td = 0; td < 8; ++td) { Sacc[td] = Sacc[td] * dec[td];
                Sacc[td] = mfma16(v0, *(const bf16x8*)(kdt + (td * 16 + fr) * 72 + fq * 8), Sacc[td]);
                Sacc[td] = mfma16(v1, *(const bf16x8*)(kdt + (td * 16 + fr) * 72 + 32 + fq * 8), Sacc[td]); }
        }
        LDSBAR();
        {
            const int ti = wid & 3, dv0 = (wid >> 2) * 4;
#pragma unroll
            for (int d = 0; d < 4; ++d)
#pragma unroll
                for (int jj = 0; jj < 4; ++jj) ob[(ti * 16 + fq * 4 + jj) * 132 + (dv0 + d) * 16 + fr] = oacc[d][jj];
        }
        LDSBAR();
        {
            float o[16]; float ss = 0.f;
#pragma unroll
            for (int q4 = 0; q4 < 4; ++q4) { const f32x4 v = *(const f32x4*)(ob + et * 132 + part * 16 + q4 * 4); o[q4 * 4] = v[0]; o[q4 * 4 + 1] = v[1]; o[q4 * 4 + 2] = v[2]; o[q4 * 4 + 3] = v[3];
                ss += v[0] * v[0] + v[1] * v[1] + v[2] * v[2] + v[3] * v[3]; }
            ss += __shfl_xor(ss, 1); ss += __shfl_xor(ss, 2); ss += __shfl_xor(ss, 4);
            const float r = rsqrtf(ss * (1.f / 128.f) + EPSN);
            u32x4 w0, w1;
#pragma unroll
            for (int q = 0; q < 4; ++q) {
                w0[q] = cvt_pk_bf16(o[2 * q] * r * gnv[2 * q] * siluf_(bflo(g0[q])), o[2 * q + 1] * r * gnv[2 * q + 1] * siluf_(bfhi(g0[q])));
                w1[q] = cvt_pk_bf16(o[8 + 2 * q] * r * gnv[8 + 2 * q] * siluf_(bflo(g1[q])), o[8 + 2 * q + 1] * r * gnv[8 + 2 * q + 1] * siluf_(bfhi(g1[q]))); }
            *(u32x4*)(O + erow * 1024 + h * 128 + part * 16) = w0; *(u32x4*)(O + erow * 1024 + h * 128 + part * 16 + 8) = w1;
        }
    }
#undef HG_FETCH
    float* so = p.out + OO_HGP + (((size_t)j * 8 + b) * 4 + h) * 16384;
#pragma unroll
    for (int td = 0; td < 8; ++td) *(f32x4*)(so + (size_t)(td * 16 + fr) * 128 + wid * 16 + fq * 4) = Sacc[td];
    LDSBAR();
}

__device__ void lru_scan_prompt(KParams& p, int j, int b, int cg16, unsigned char* shm) {
    const int tid = tid_opaque(), cl = tid & 15, ch = cg16 * 16 + cl, seg = tid >> 4;
    const float* LA = (const float*)(p.ws + WS_ON); const float* LBT = LA + (size_t)NTOK * 512;
    const bf16_t* PROJ = (const bf16_t*)(p.ws + WS_PROJ); bf16_t* O = (bf16_t*)(p.ws + WS_O);
    float* sA = (float*)shm; float* sH = sA + 512;
    const size_t r0 = (size_t)b * 2048 + seg * 64;
    float A = 1.f, H = 0.f;
    for (int t0 = 0; t0 < 64; t0 += 16) { float av[16], bv[16];
#pragma unroll
        for (int t = 0; t < 16; ++t) { av[t] = LA[(r0 + t0 + t) * 512 + ch]; bv[t] = LBT[(r0 + t0 + t) * 512 + ch]; }
#pragma unroll
        for (int t = 0; t < 16; ++t) { H = av[t] * H + bv[t]; A *= av[t]; } }
    __syncthreads();
    sA[tid] = A; sH[tid] = H;
    __syncthreads();
    float hc = 0.f;
    for (int s2 = 0; s2 < seg; ++s2) hc = sA[s2 * 16 + cl] * hc + sH[s2 * 16 + cl];
    for (int t0 = 0; t0 < 64; t0 += 16) { float av[16], bv[16], yv[16];
#pragma unroll
        for (int t = 0; t < 16; ++t) { av[t] = LA[(r0 + t0 + t) * 512 + ch]; bv[t] = LBT[(r0 + t0 + t) * 512 + ch]; yv[t] = bf2f(PROJ[(r0 + t0 + t) * 3072 + 2048 + ch]); }
#pragma unroll
        for (int t = 0; t < 16; ++t) { hc = av[t] * hc + bv[t]; O[(r0 + t0 + t) * 1024 + 512 + ch] = f2bf(geluf_(yv[t]) * hc); } }
    if (seg == 31) p.out[OO_LHP + ((size_t)j * 8 + b) * 512 + ch] = hc;
}
__device__ void lru_scan_sample(KParams& p, int j, int b) {
    const int ch = tid_opaque();
    const float* LA = (const float*)(p.ws + WS_ON); const float* LBT = LA + (size_t)NTOK * 512;
    const bf16_t* PROJ = (const bf16_t*)(p.ws + WS_PROJ); bf16_t* O = (bf16_t*)(p.ws + WS_O);
    float hc = p.in[I_SLH][((size_t)j * 128 + b) * 512 + ch];
    const size_t r0 = NPR + (size_t)b * 8;
#pragma unroll
    for (int t = 0; t < 8; ++t) { const float a = LA[(r0 + t) * 512 + ch], bt = LBT[(r0 + t) * 512 + ch]; hc = a * hc + bt;
        const float yb = bf2f(PROJ[(r0 + t) * 3072 + 2048 + ch]);
        O[(r0 + t) * 1024 + 512 + ch] = f2bf(geluf_(yb) * hc); }
    p.out[OO_LHS + ((size_t)j * 128 + b) * 512 + ch] = hc;
}
__device__ void phase_even_scan(KParams& p, int j, unsigned char* shm) {
    const int bid = bid_opaque(), G = gridDim.x;
    for (int w = bid - 32; w < 896; w += G - 32) {
        if (w < 512) { const int v = w + 32; hgrn_unit(p, j, v >> 2, v & 3, shm); }
        else if (w < 768) lru_scan_prompt(p, j, (w - 512) >> 5, (w - 512) & 31, shm);
        else lru_scan_sample(p, j, w - 768);
    }
}

__device__ void phase_conv_ssm(KParams& p, int j) {
    const bf16_t* PROJ = (const bf16_t*)(p.ws + WS_PROJ); bf16_t* XBC = (bf16_t*)(p.ws + WS_U);
    const float* cw = p.in[I_SCW] + (size_t)j * 4 * 3072; const float* cb = p.in[I_SCB] + (size_t)j * 3072;
    for (int idx = bid_opaque() * 512 + tid_opaque(); idx < 512 * 384; idx += gridDim.x * 512) {
        const int rb = idx / 384, c8 = (idx % 384) * 8, r0 = rb * 32, t0 = r0 & 2047, b = r0 >> 11;
        float w[4][8], bias[8], h[3][8];
#pragma unroll
        for (int k = 0; k < 4; ++k) { const f32x4 a = *(const f32x4*)(cw + k * 3072 + c8), c = *(const f32x4*)(cw + k * 3072 + c8 + 4);
            w[k][0] = a[0]; w[k][1] = a[1]; w[k][2] = a[2]; w[k][3] = a[3]; w[k][4] = c[0]; w[k][5] = c[1]; w[k][6] = c[2]; w[k][7] = c[3]; }
        { const f32x4 a = *(const f32x4*)(cb + c8), c = *(const f32x4*)(cb + c8 + 4); bias[0] = a[0]; bias[1] = a[1]; bias[2] = a[2]; bias[3] = a[3]; bias[4] = c[0]; bias[5] = c[1]; bias[6] = c[2]; bias[7] = c[3]; }
#pragma unroll
        for (int k = 0; k < 3; ++k) { u32x4 hw = (u32x4){0u, 0u, 0u, 0u}; if (t0 != 0) hw = *(const u32x4*)(PROJ + (size_t)(r0 - 3 + k) * 5376 + 2048 + c8);
#pragma unroll
            for (int q = 0; q < 4; ++q) { h[k][2 * q] = bflo(hw[q]); h[k][2 * q + 1] = bfhi(hw[q]); } }
        for (int rr = 0; rr < 32; rr += 8) { u32x4 in[8];
#pragma unroll
            for (int e = 0; e < 8; ++e) in[e] = *(const u32x4*)(PROJ + (size_t)(r0 + rr + e) * 5376 + 2048 + c8);
#pragma unroll
            for (int e = 0; e < 8; ++e) { float cur[8]; u32x4 ow;
#pragma unroll
                for (int q = 0; q < 4; ++q) { cur[2 * q] = bflo(in[e][q]); cur[2 * q + 1] = bfhi(in[e][q]); }
#pragma unroll
                for (int q = 0; q < 4; ++q) { const float o0 = bias[2 * q] + w[0][2 * q] * h[0][2 * q] + w[1][2 * q] * h[1][2 * q] + w[2][2 * q] * h[2][2 * q] + w[3][2 * q] * cur[2 * q];
                    const float o1 = bias[2 * q + 1] + w[0][2 * q + 1] * h[0][2 * q + 1] + w[1][2 * q + 1] * h[1][2 * q + 1] + w[2][2 * q + 1] * h[2][2 * q + 1] + w[3][2 * q + 1] * cur[2 * q + 1];
                    ow[q] = cvt_pk_bf16(siluf_(o0), siluf_(o1)); }
                *(u32x4*)(XBC + (size_t)(r0 + rr + e) * 3072 + c8) = ow;
#pragma unroll
                for (int q = 0; q < 8; ++q) { h[0][q] = h[1][q]; h[1][q] = h[2][q]; h[2][q] = cur[q]; } } }
        if (t0 + 32 == 2048) { float* dst = p.out + OO_SCP + (((size_t)j * 8 + b) * 3) * 3072 + c8;
#pragma unroll
            for (int k = 0; k < 3; ++k)
#pragma unroll
                for (int q = 0; q < 8; ++q) dst[(size_t)k * 3072 + q] = h[k][q]; }
    }
    for (int idx = bid_opaque() * 512 + tid_opaque(); idx < 1024 * 384; idx += gridDim.x * 512) {
        const int row = NPR + idx / 384, c8 = (idx % 384) * 8;
        int t, L, b; const bool pr = row < NPR;
        if (pr) { t = row & 2047; L = 2048; b = row >> 11; } else { t = (row - NPR) & 7; L = 8; b = (row - NPR) >> 3; }
        float o[8], last[8];
#pragma unroll
        for (int q = 0; q < 8; ++q) o[q] = cb[c8 + q];
#pragma unroll
        for (int k = 0; k < 4; ++k) { const int m = t + k; float v[8];
            if (m >= 3) { const u32x4 w = *(const u32x4*)(PROJ + (size_t)(row + k - 3) * 5376 + 2048 + c8);
#pragma unroll
                for (int q = 0; q < 4; ++q) { v[2 * q] = bflo(w[q]); v[2 * q + 1] = bfhi(w[q]); } }
            else if (!pr) { const float* sp = p.in[I_SSC] + (((size_t)j * 128 + b) * 3 + m) * 3072 + c8;
#pragma unroll
                for (int q = 0; q < 8; ++q) v[q] = sp[q]; }
            else {
#pragma unroll
                for (int q = 0; q < 8; ++q) v[q] = 0.f; }
#pragma unroll
            for (int q = 0; q < 8; ++q) { o[q] += cw[k * 3072 + c8 + q] * v[q]; if (k == 3) last[q] = v[q]; } }
        u32x4 w;
#pragma unroll
        for (int q = 0; q < 4; ++q) w[q] = cvt_pk_bf16(siluf_(o[2 * q]), siluf_(o[2 * q + 1]));
        *(u32x4*)(XBC + (size_t)row * 3072 + c8) = w;
        if (t >= L - 3) { const int r = t - (L - 3);
            float* dst = pr ? p.out + OO_SCP + (((size_t)j * 8 + b) * 3 + r) * 3072 + c8 : p.out + OO_SCS + (((size_t)j * 128 + b) * 3 + r) * 3072 + c8;
#pragma unroll
            for (int q = 0; q < 8; ++q) dst[q] = last[q]; }
    }
    float* DT = (float*)(p.ws + WS_DT); float* DA = DT + (size_t)NTOK * 32;
    for (int idx = bid_opaque() * 512 + tid_opaque(); idx < NTOK * 32; idx += gridDim.x * 512) {
        const int row = idx >> 5, h = idx & 31;
        const float dt = softplusf_(bf2f(PROJ[(size_t)row * 5376 + 5120 + h]) + p.in[I_SDTB][j * 32 + h]);
        DT[idx] = dt; DA[idx] = __expf(-dt * __expf(p.in[I_SALOG][j * 32 + h]));
    }
}

__device__ void ssd_unit(KParams& p, int j, int s, int h, unsigned char* shm) {
    const int tid = tid_opaque(), pp = tid & 63, nq = tid >> 6, g = h >> 3;
    const bf16_t* PROJ = (const bf16_t*)(p.ws + WS_PROJ); const bf16_t* XBC = (const bf16_t*)(p.ws + WS_U); bf16_t* O = (bf16_t*)(p.ws + WS_O);
    const float* DT = (const float*)(p.ws + WS_DT); const float* DA = DT + (size_t)NTOK * 32;
    u64* GSS = (u64*)(p.ws + WS_RSS) + 8 * (size_t)NTOK + (size_t)j * NTOK * 4;
    float* Bs = (float*)shm; float* Cs = Bs + 16 * 128; float* xs = Cs + 16 * 128; float* dts = xs + 16 * 64; float* das = dts + 16; float* yp = das + 16;
    const int base = seq_base(s), L = seq_len(s), nb = L < 16 ? L : 16;
    const float Dh = p.in[I_SD][j * 32 + h];
    float S[16];
    if (s >= 8) { const float* s0 = p.in[I_SSM] + ((((size_t)j * 128 + (s - 8)) * 32 + h) * 64 + pp) * 128 + nq * 16;
#pragma unroll
        for (int i4 = 0; i4 < 4; ++i4) { const f32x4 v = *(const f32x4*)(s0 + i4 * 4); S[i4 * 4] = v[0]; S[i4 * 4 + 1] = v[1]; S[i4 * 4 + 2] = v[2]; S[i4 * 4 + 3] = v[3]; } }
    else {
#pragma unroll
        for (int i = 0; i < 16; ++i) S[i] = 0.f; }
    for (int t0 = 0; t0 < L; t0 += nb) {
        __syncthreads();
        for (int idx = tid; idx < nb * 128; idx += 512) { const int t = idx >> 7, n = idx & 127; const size_t ro = (size_t)(base + t0 + t) * 3072;
            Bs[idx] = bf2f(XBC[ro + 2048 + g * 128 + n]); Cs[idx] = bf2f(XBC[ro + 2560 + g * 128 + n]); }
        for (int idx = tid; idx < nb * 64; idx += 512) { const int t = idx >> 6, q = idx & 63; xs[idx] = bf2f(XBC[(size_t)(base + t0 + t) * 3072 + h * 64 + q]); }
        if (tid < nb) { dts[tid] = DT[(size_t)(base + t0 + tid) * 32 + h]; das[tid] = DA[(size_t)(base + t0 + tid) * 32 + h]; }
        __syncthreads();
#pragma unroll 2
        for (int t = 0; t < nb; ++t) { { const float xdt = xs[t * 64 + pp] * dts[t], da = das[t]; float y = 0.f;
#pragma unroll
                for (int i4 = 0; i4 < 4; ++i4) { const f32x4 b4 = *(const f32x4*)(Bs + t * 128 + nq * 16 + i4 * 4), c4 = *(const f32x4*)(Cs + t * 128 + nq * 16 + i4 * 4);
#pragma unroll
                    for (int e = 0; e < 4; ++e) { const int i = i4 * 4 + e; S[i] = da * S[i] + xdt * b4[e]; y += c4[e] * S[i]; } }
                yp[(t * 8 + nq) * 64 + pp] = y; } }
        __syncthreads();
        for (int t = nq; t < nb; t += 8) { const int row = base + t0 + t; float y = Dh * xs[t * 64 + pp];
#pragma unroll
            for (int q = 0; q < 8; ++q) y += yp[(t * 8 + q) * 64 + pp];
            const float z = bf2f(PROJ[(size_t)row * 5376 + h * 64 + pp]);
            y *= siluf_(z);
            O[(size_t)row * 2048 + h * 64 + pp] = f2bf(y);
            const float ss = wave_sum(y * y);
            if (pp == 0) atomicAdd(GSS + (size_t)g * NTOK + row, (u64)(ss * FXS)); }
    }
    float* so = s < 8 ? p.out + OO_SSP + ((((size_t)j * 8 + s) * 32 + h) * 64 + pp) * 128 + nq * 16 : p.out + OO_SSS + ((((size_t)j * 128 + (s - 8)) * 32 + h) * 64 + pp) * 128 + nq * 16;
#pragma unroll
    for (int i4 = 0; i4 < 4; ++i4) { f32x4 v; v[0] = S[i4 * 4]; v[1] = S[i4 * 4 + 1]; v[2] = S[i4 * 4 + 2]; v[3] = S[i4 * 4 + 3]; *(f32x4*)(so + i4 * 4) = v; }
}

__device__ void ssd_prompt_unit(KParams& p, int j, int b, int h, unsigned char* shm) {
    const int tid = tid_opaque(), lane = tid & 63, wid = tid >> 6, fr = lane & 15, fq = lane >> 4, g = h >> 3;
    const bf16_t* PROJ = (const bf16_t*)(p.ws + WS_PROJ); const bf16_t* XBC = (const bf16_t*)(p.ws + WS_U); bf16_t* O = (bf16_t*)(p.ws + WS_O);
    const float* DT = (const float*)(p.ws + WS_DT);
    u64* GSS = (u64*)(p.ws + WS_RSS) + 8 * (size_t)NTOK + (size_t)j * NTOK * 4;
    constexpr int CM = 0, BM = 17408, BMT = 34816, XT = 53248, XWT = 62464, PP = 71680, SB = 80896, CUM = 98304, DTS = 98560, GP = 98816;
    bf16_t* cm = (bf16_t*)(shm + CM); bf16_t* bm = (bf16_t*)(shm + BM); bf16_t* bmt = (bf16_t*)(shm + BMT); bf16_t* xt = (bf16_t*)(shm + XT); bf16_t* xwt = (bf16_t*)(shm + XWT);
    bf16_t* pp = (bf16_t*)(shm + PP); bf16_t* sb = (bf16_t*)(shm + SB); float* cum = (float*)(shm + CUM); float* dts = (float*)(shm + DTS); float* gpart = (float*)(shm + GP);
    const float Ah = -__expf(p.in[I_SALOG][j * 32 + h]), Dh = p.in[I_SD][j * 32 + h];
    const int pt = wid >> 1, nt0 = (wid & 1) * 4;
    f32x4 Sacc[4];
#pragma unroll
    for (int q = 0; q < 4; ++q) Sacc[q] = (f32x4){0.f, 0.f, 0.f, 0.f};
    u32x4 cw[2], bw[2], xw; float dtv = 0.f; bf16_t zv[8];
    const int xrow = tid >> 3, xc8 = tid & 7;
#define SSD_FETCH(cc) do { const size_t rn = (size_t)b * 2048 + (cc) * 64; \
        _Pragma("unroll") for (int q = 0; q < 2; ++q) { const int ch = tid + q * 512, row = ch >> 4, c16 = ch & 15; const size_t ro = (rn + row) * 3072 + g * 128 + c16 * 8; \
            bw[q] = *(const u32x4*)(XBC + ro + 2048); cw[q] = *(const u32x4*)(XBC + ro + 2560); } \
        xw = *(const u32x4*)(XBC + (rn + xrow) * 3072 + h * 64 + xc8 * 8); \
        if (wid == 0) dtv = DT[(rn + lane) * 32 + h]; \
        _Pragma("unroll") for (int q = 0; q < 2; ++q) _Pragma("unroll") for (int jj = 0; jj < 4; ++jj) \
            zv[q * 4 + jj] = PROJ[(rn + (wid >> 1) * 16 + fq * 4 + jj) * 5376 + h * 64 + ((wid & 1) * 2 + q) * 16 + fr]; } while (0)
    SSD_FETCH(0);
    for (int c = 0; c < 32; ++c) {
        const size_t r0 = (size_t)b * 2048 + c * 64;
        if (c > 0 && wid == 0) atomicAdd(GSS + (size_t)g * NTOK + (r0 - 64) + lane, (u64)((gpart[lane] + gpart[64 + lane]) * FXS));
        if (wid == 0) { const float dt = dtv; float la = dt * Ah;
#pragma unroll
            for (int o = 1; o < 64; o <<= 1) { const float t = __shfl_up(la, o); if (lane >= o) la += t; }
            cum[lane] = la; dts[lane] = dt; }
        bf16_t zc[8];
#pragma unroll
        for (int q = 0; q < 8; ++q) zc[q] = zv[q];
        LDSBAR();
        {
#pragma unroll
            for (int q = 0; q < 2; ++q) { const int ch = tid + q * 512, row = ch >> 4, c16 = ch & 15;
                *(u32x4*)(cm + row * 136 + c16 * 8) = cw[q]; *(u32x4*)(bm + row * 136 + c16 * 8) = bw[q];
#pragma unroll
                for (int e = 0; e < 4; ++e) { const int rs = row ^ ((c16 & 7) << 3); bmt[(c16 * 8 + 2 * e) * 72 + rs] = (bf16_t)(bw[q][e] & 0xffffu); bmt[(c16 * 8 + 2 * e + 1) * 72 + rs] = (bf16_t)(bw[q][e] >> 16); } }
            const float wsc = __expf(cum[63] - cum[xrow]) * dts[xrow];
#pragma unroll
            for (int e = 0; e < 4; ++e) { const bf16_t lo = (bf16_t)(xw[e] & 0xffffu), hi = (bf16_t)(xw[e] >> 16);
                const int xs_ = xrow ^ (xc8 << 3);
                xt[(xc8 * 8 + 2 * e) * 72 + xs_] = lo; xt[(xc8 * 8 + 2 * e + 1) * 72 + xs_] = hi;
                xwt[(xc8 * 8 + 2 * e) * 72 + xs_] = f2bf(bf2f(lo) * wsc); xwt[(xc8 * 8 + 2 * e + 1) * 72 + xs_] = f2bf(bf2f(hi) * wsc); }
#pragma unroll
            for (int q = 0; q < 4; ++q)
#pragma unroll
                for (int jj = 0; jj < 4; ++jj) sb[(pt * 16 + fq * 4 + jj) * 136 + (nt0 + q) * 16 + fr] = f2bf(Sacc[q][jj]);
        }
        if (c + 1 < 32) SSD_FETCH(c + 1);
        LDSBAR();
        {
            const int ti = wid >> 1, si0 = (wid & 1) * 2;
#pragma unroll
            for (int q = 0; q < 2; ++q) { const int si = si0 + q; f32x4 a = (f32x4){0.f, 0.f, 0.f, 0.f};
                if (si <= ti) {
#pragma unroll
                    for (int k4 = 0; k4 < 4; ++k4) a = mfma16(*(const bf16x8*)(cm + (ti * 16 + fr) * 136 + k4 * 32 + fq * 8), *(const bf16x8*)(bm + (si * 16 + fr) * 136 + k4 * 32 + fq * 8), a); }
                const int s2 = si * 16 + fr; const float cs = cum[s2], ds = dts[s2];
#pragma unroll
                for (int jj = 0; jj < 4; ++jj) { const int t = ti * 16 + fq * 4 + jj; const float v = a[jj] * __expf(cum[t] - cs) * ds; pp[t * 72 + s2] = f2bf(s2 <= t ? v : 0.f); } }
        }
        LDSBAR();
        {
            const int ti = wid >> 1, pi0 = (wid & 1) * 2;
            f32x4 oa[2];
#pragma unroll
            for (int q = 0; q < 2; ++q) oa[q] = (f32x4){0.f, 0.f, 0.f, 0.f};
#pragma unroll
            for (int k4 = 0; k4 < 4; ++k4) { const bf16x8 a = *(const bf16x8*)(cm + (ti * 16 + fr) * 136 + k4 * 32 + fq * 8);
#pragma unroll
                for (int q = 0; q < 2; ++q) oa[q] = mfma16(a, *(const bf16x8*)(sb + ((pi0 + q) * 16 + fr) * 136 + k4 * 32 + fq * 8), oa[q]); }
            float ec[4];
#pragma unroll
            for (int jj = 0; jj < 4; ++jj) ec[jj] = __expf(cum[ti * 16 + fq * 4 + jj]);
#pragma unroll
            for (int q = 0; q < 2; ++q)
#pragma unroll
                for (int jj = 0; jj < 4; ++jj) oa[q][jj] *= ec[jj];
#pragma unroll
            for (int k2 = 0; k2 < 2; ++k2) { const bf16x8 a = *(const bf16x8*)(pp + (ti * 16 + fr) * 72 + k2 * 32 + fq * 8);
#pragma unroll
                for (int q = 0; q < 2; ++q) oa[q] = mfma16(a, *(const bf16x8*)(xt + ((pi0 + q) * 16 + fr) * 72 + ((k2 * 32 + fq * 8) ^ (((((pi0 + q) * 16 + fr) >> 3) & 7) << 3))), oa[q]); }
            float ss[4] = {0.f, 0.f, 0.f, 0.f};
#pragma unroll
            for (int q = 0; q < 2; ++q)
#pragma unroll
                for (int jj = 0; jj < 4; ++jj) { const int t = ti * 16 + fq * 4 + jj, pc = (pi0 + q) * 16 + fr; const size_t row = r0 + t;
                    float y = oa[q][jj] + Dh * bf2f(xt[pc * 72 + (t ^ (((pc >> 3) & 7) << 3))]);
                    y *= siluf_(bf2f(zc[q * 4 + jj]));
                    O[row * 2048 + h * 64 + pc] = f2bf(y); ss[jj] += y * y; }
#pragma unroll
            for (int jj = 0; jj < 4; ++jj) { float v = ss[jj]; v += __shfl_xor(v, 1); v += __shfl_xor(v, 2); v += __shfl_xor(v, 4); v += __shfl_xor(v, 8);
                if (fr == 0) gpart[(wid & 1) * 64 + ti * 16 + fq * 4 + jj] = v; }
            const float dec = __expf(cum[63]);
            const int xsw = (((pt * 16 + fr) >> 3) & 7) << 3;
            const bf16x8 a0 = *(const bf16x8*)(xwt + (pt * 16 + fr) * 72 + ((fq * 8) ^ xsw)), a1 = *(const bf16x8*)(xwt + (pt * 16 + fr) * 72 + ((32 + fq * 8) ^ xsw));
#pragma unroll
            for (int q = 0; q < 4; ++q) { Sacc[q] = Sacc[q] * dec;
                const int bsw = (((((nt0 + q) * 16 + fr) >> 3) & 7) << 3);
                Sacc[q] = mfma16(a0, *(const bf16x8*)(bmt + ((nt0 + q) * 16 + fr) * 72 + ((fq * 8) ^ bsw)), Sacc[q]);
                Sacc[q] = mfma16(a1, *(const bf16x8*)(bmt + ((nt0 + q) * 16 + fr) * 72 + ((32 + fq * 8) ^ bsw)), Sacc[q]); }
        }
        LDSBAR();
    }
#undef SSD_FETCH
    if (wid == 0) atomicAdd(GSS + (size_t)g * NTOK + ((size_t)b * 2048 + 31 * 64) + lane, (u64)((gpart[lane] + gpart[64 + lane]) * FXS));
    float* so = p.out + OO_SSP + ((((size_t)j * 8 + b) * 32 + h) * 64) * 128;
#pragma unroll
    for (int q = 0; q < 4; ++q)
#pragma unroll
        for (int jj = 0; jj < 4; ++jj) so[(size_t)(pt * 16 + fq * 4 + jj) * 128 + (nt0 + q) * 16 + fr] = Sacc[q][jj];
}


__device__ void ssd_sample_loop(KParams& p, int j, int u0, int ustep, unsigned char* shm) {
    const int tid = tid_opaque(), pp = tid & 63, nq = tid >> 6;
    const bf16_t* PROJ = (const bf16_t*)(p.ws + WS_PROJ); const bf16_t* XBC = (const bf16_t*)(p.ws + WS_U); bf16_t* O = (bf16_t*)(p.ws + WS_O);
    const float* DT = (const float*)(p.ws + WS_DT); const float* DA = DT + (size_t)NTOK * 32;
    u64* GSS = (u64*)(p.ws + WS_RSS) + 8 * (size_t)NTOK + (size_t)j * NTOK * 4;
    float* Bs = (float*)shm; float* Cs = Bs + 8 * 128; float* xs = Cs + 8 * 128; float* dts = xs + 8 * 64; float* das = dts + 8; float* yp = das + 8;
    float* stg = (float*)(shm + 32768);
    f32x4 s0[4]; bf16_t bv[2], cv[2], xv, zv; float dtv = 0.f, dav = 0.f;
#define SS_FETCH(uu) do { const int b_ = (uu) >> 5, h_ = (uu) & 31, g_ = h_ >> 3; const size_t base_ = NPR + (size_t)b_ * 8; \
        const float* sp = p.in[I_SSM] + (((size_t)j * 128 + b_) * 32 + h_) * 8192 + tid * 4; \
        _Pragma("unroll") for (int i4 = 0; i4 < 4; ++i4) s0[i4] = *(const f32x4*)(sp + i4 * 2048); \
        _Pragma("unroll") for (int q = 0; q < 2; ++q) { const int idx = tid + q * 512, t = idx >> 7, n = idx & 127; const size_t ro = (base_ + t) * 3072; bv[q] = XBC[ro + 2048 + g_ * 128 + n]; cv[q] = XBC[ro + 2560 + g_ * 128 + n]; } \
        xv = XBC[(base_ + nq) * 3072 + h_ * 64 + pp]; zv = PROJ[(base_ + nq) * 5376 + h_ * 64 + pp]; \
        if (tid < 8) { dtv = DT[(base_ + tid) * 32 + h_]; dav = DA[(base_ + tid) * 32 + h_]; } } while (0)
    if (u0 < 4096) SS_FETCH(u0);
    for (int u = u0; u < 4096; u += ustep) {
        const int b = u >> 5, h = u & 31, g = h >> 3; const size_t base = NPR + (size_t)b * 8;
        const float Dh = p.in[I_SD][j * 32 + h];
        LDSBAR();
#pragma unroll
        for (int i4 = 0; i4 < 4; ++i4) { const int ci = tid + i4 * 512; *(f32x4*)(stg + (ci >> 5) * 132 + (ci & 31) * 4) = s0[i4]; }
#pragma unroll
        for (int q = 0; q < 2; ++q) { Bs[tid + q * 512] = bf2f(bv[q]); Cs[tid + q * 512] = bf2f(cv[q]); }
        xs[tid] = bf2f(xv); const float zc = bf2f(zv);
        if (tid < 8) { dts[tid] = dtv; das[tid] = dav; }
        LDSBAR();
        float S[16];
#pragma unroll
        for (int i4 = 0; i4 < 4; ++i4) { const f32x4 v = *(const f32x4*)(stg + pp * 132 + nq * 16 + i4 * 4); S[i4 * 4] = v[0]; S[i4 * 4 + 1] = v[1]; S[i4 * 4 + 2] = v[2]; S[i4 * 4 + 3] = v[3]; }
        if (u + ustep < 4096) SS_FETCH(u + ustep);
#pragma unroll 2
        for (int t = 0; t < 8; ++t) { const float xdt = xs[t * 64 + pp] * dts[t], da = das[t]; float y = 0.f;
#pragma unroll
            for (int i4 = 0; i4 < 4; ++i4) { const f32x4 b4 = *(const f32x4*)(Bs + t * 128 + nq * 16 + i4 * 4), c4 = *(const f32x4*)(Cs + t * 128 + nq * 16 + i4 * 4);
#pragma unroll
                for (int e = 0; e < 4; ++e) { const int i = i4 * 4 + e; S[i] = da * S[i] + xdt * b4[e]; y += c4[e] * S[i]; } }
            yp[(t * 8 + nq) * 64 + pp] = y; }
        LDSBAR();
        { const int t = nq; const size_t row = base + t; float y = Dh * xs[t * 64 + pp];
#pragma unroll
            for (int q = 0; q < 8; ++q) y += yp[(t * 8 + q) * 64 + pp];
            y *= siluf_(zc);
            O[row * 2048 + h * 64 + pp] = f2bf(y);
            const float ss = wave_sum(y * y);
            if (pp == 0) atomicAdd(GSS + (size_t)g * NTOK + row, (u64)(ss * FXS)); }
#pragma unroll
        for (int i4 = 0; i4 < 4; ++i4) { f32x4 v; v[0] = S[i4 * 4]; v[1] = S[i4 * 4 + 1]; v[2] = S[i4 * 4 + 2]; v[3] = S[i4 * 4 + 3]; *(f32x4*)(stg + pp * 132 + nq * 16 + i4 * 4) = v; }
        LDSBAR();
        float* so = p.out + OO_SSS + (((size_t)j * 128 + b) * 32 + h) * 8192 + tid * 4;
#pragma unroll
        for (int i4 = 0; i4 < 4; ++i4) { const int ci = tid + i4 * 512; *(f32x4*)(so + i4 * 2048) = *(const f32x4*)(stg + (ci >> 5) * 132 + (ci & 31) * 4); }
    }
#undef SS_FETCH
}

__device__ void phase_ssd(KParams& p, int j, unsigned char* shm) {
    const int bid = bid_opaque(), G = gridDim.x;
    for (int u = bid; u < 256; u += G) ssd_prompt_unit(p, j, u >> 5, u & 31, shm);
    ssd_sample_loop(p, j, bid, G, shm);
}
__device__ void phase_gnorm(KParams& p, int j) {
    const bf16_t* O = (const bf16_t*)(p.ws + WS_O); bf16_t* ON = (bf16_t*)(p.ws + WS_ON);
    const u64* GSS = (const u64*)(p.ws + WS_RSS) + 8 * (size_t)NTOK + (size_t)j * NTOK * 4;
    const float* gn = p.in[I_SGN] + (size_t)j * 2048;
    for (int idx = bid_opaque() * 512 + tid_opaque(); idx < NTOK * 256; idx += gridDim.x * 512) {
        const int row = idx >> 8, c8 = (idx & 255) * 8;
        const float r = rsqrtf((float)GSS[(size_t)(c8 >> 9) * NTOK + row] * (FXI / 512.f) + EPSN);
        const u32x4 w = *(const u32x4*)(O + (size_t)row * 2048 + c8); u32x4 o;
#pragma unroll
        for (int q = 0; q < 4; ++q) o[q] = cvt_pk_bf16(bflo(w[q]) * r * gn[c8 + 2 * q], bfhi(w[q]) * r * gn[c8 + 2 * q + 1]);
        *(u32x4*)(ON + (size_t)row * 2048 + c8) = o;
    }
}

__device__ void phase_final(KParams& p) {
    const bf16_t* XH = (const bf16_t*)(p.ws + WS_XN); const u64* RSN = (const u64*)(p.ws + WS_RSS) + RSSN_OFF + 4 * (size_t)NTOK;
    const float* gm = p.in[I_GFIN];
    const int stride = gridDim.x * 512;
    for (int idx0 = bid_opaque() * 512 + tid_opaque(); idx0 < NTOK * 128; idx0 += 2 * stride) { u32x4 xw[2]; float rr[2];
#pragma unroll
        for (int k = 0; k < 2; ++k) { const int idx = idx0 + k * stride; xw[k] = (u32x4){0u, 0u, 0u, 0u}; rr[k] = 0.f;
            if (idx < NTOK * 128) { const int row = idx >> 7, c8 = (idx & 127) * 8; xw[k] = *(const u32x4*)(XH + (size_t)row * 1024 + c8); rr[k] = (float)RSN[row]; } }
#pragma unroll
        for (int k = 0; k < 2; ++k) { const int idx = idx0 + k * stride;
            if (idx < NTOK * 128) { const int row = idx >> 7, c8 = (idx & 127) * 8; const float r = rsqrtf(rr[k] * (FXI / 1024.f) + EPSN);
                const f32x4 g0 = *(const f32x4*)(gm + c8), g1 = *(const f32x4*)(gm + c8 + 4); f32x4 y0, y1;
                y0[0] = bflo(xw[k][0]) * r * g0[0]; y0[1] = bfhi(xw[k][0]) * r * g0[1]; y0[2] = bflo(xw[k][1]) * r * g0[2]; y0[3] = bfhi(xw[k][1]) * r * g0[3];
                y1[0] = bflo(xw[k][2]) * r * g1[0]; y1[1] = bfhi(xw[k][2]) * r * g1[1]; y1[2] = bflo(xw[k][3]) * r * g1[2]; y1[3] = bfhi(xw[k][3]) * r * g1[3];
                *(f32x4*)(p.out + OO_Y + (size_t)row * 1024 + c8) = y0; *(f32x4*)(p.out + OO_Y + (size_t)row * 1024 + c8 + 4) = y1; } }
    }
}

__global__ void __launch_bounds__(512, 2) mega(Params p_) {
    extern __shared__ __attribute__((aligned(16))) unsigned char shm[];
    cg::grid_group grid = cg::this_grid();
    LAS unsigned char* lds = (LAS unsigned char*)shm;
    const int G = gridDim.x;
    unsigned* bar = (unsigned*)(p_.ws + WS_BAR);
    volatile LAS unsigned* st = (volatile LAS unsigned*)(lds + 131072);
    if (threadIdx.x == 0) { st[0] = 0u; st[1] = 0u; st[2] = 0u; st[3] = 0u; }
    if (blockIdx.x == 0) for (int i = threadIdx.x; i < 2 * XCD_BAR_WORDS; i += 512) bar[i] = 0u;
    __syncthreads();
    XcdBarrier xb; xb.bar = bar; xb.x = 0u; xb.st = st; xb.expect = 0u;
    XcdBarrier xb2; xb2.bar = bar + XCD_BAR_WORDS; xb2.x = 0u; xb2.st = st + 2; xb2.expect = 0u;
    const int ph_lo = p_.ph_lo, ph_hi = p_.ph_hi;
    for (int ph = ph_lo; ph < ph_hi; ++ph) {
        const int bid = bid_opaque();
        LAS unsigned char* lds_l = lds; asm volatile("" : "+s"(lds_l));
        unsigned char* shm_l = (unsigned char*)lds_l;
        KParams* kp = (KParams*)__builtin_amdgcn_kernarg_segment_ptr();
        asm volatile("" : "+s"(kp));
        KParams& p = *kp;
        unsigned char* ws = p.ws;
        bf16_t* W = (bf16_t*)(ws + WS_W);
        bf16_t* XH = (bf16_t*)(ws + WS_XN);
        bf16_t* EB = (bf16_t*)(ws + WS_EB); bf16_t* PB = (bf16_t*)(ws + WS_PB);
        bf16_t* PROJ = (bf16_t*)(ws + WS_PROJ); bf16_t* U = (bf16_t*)(ws + WS_U); bf16_t* O = (bf16_t*)(ws + WS_O);
        u64* RSS = (u64*)(ws + WS_RSS);
        if (ph == 0) phase_init(p, shm_l);
        else {
            const int i = (ph - 1) / NPH_PER_LAYER, s = (ph - 1) % NPH_PER_LAYER, j = i >> 1; const bool even = (i & 1) == 0;
            pg8::StaticOrder SO; pg8::Gemm g; g.M = NTOK;
            if (s == 0) {
                const int N = even ? 3072 : 5376;
                g.A = XH; g.Bt = W + (even ? WO_EIN + (size_t)j * 3072 * 1024 : WO_SIN + (size_t)j * 5376 * 1024); g.N = N; g.K = 1024;
                SO.init(NTOK, N, G, bid);
                EpiStore E; E.O = PROJ; E.ldc = N; E.rs0 = RSS + RSSN_OFF + (size_t)i * NTOK;
                pg8::gemm_phase<EpiStore>(lds_l, g, SO, E);
                const int r1 = SO.nwg % G;
                g.A = PB + (size_t)i * NTOK * 256; g.Bt = W + WO_U + (size_t)i * 1024 * 256; g.N = 1024; g.K = 256;
                SO.init(NTOK, 1024, G, (bid - r1 + G) % G);
                E.O = EB; E.ldc = 1024; E.rs0 = nullptr;
                pg8::gemm_phase<EpiStore>(lds_l, g, SO, E);
            } else if (s == 1) {
                if (even) { for (int u = bid; u < 1024; u += G) hgrn_prep_unit(p, j, u, shm_l); phase_conv_lru(p, j); } else phase_conv_ssm(p, j);
            } else if (s == 2) {
                if (even) {
                    if (bid < 32) hgrn_prompt_unit(p, j, bid >> 2, bid & 3, shm_l);
                    else {
                        g.A = U; g.Bt = W + WO_LRU + (size_t)j * 1024 * 512; g.N = 1024; g.K = 512; SO.init(NTOK, 1024, G - 32, bid - 32);
                        EpiLru E; E.LA = (float*)(p.ws + WS_ON); E.LBT = E.LA + (size_t)NTOK * 512; E.U = U; E.ba = p.in[I_LBA] + j * 512; E.bx = p.in[I_LBX] + j * 512; E.lam = p.in[I_LAM] + j * 512;
                        pg8::gemm_phase<EpiLru>(lds_l, g, SO, E);
                        xcd_barrier(xb2);
                        phase_even_scan(p, j, shm_l);
                    }
                } else phase_ssd(p, j, shm_l);
            } else if (s == 3) {
                ;
            } else if (s == 4 || s == 6) {
                EpiResid E; E.XH = XH;
                const u64* gss = nullptr; E.kr = nullptr;
                if (s == 4) { g.A = O; g.K = even ? 1024 : 2048; g.Bt = W + (even ? WO_EOUT + (size_t)j * 1024 * 1024 : WO_SOUT + (size_t)j * 1024 * 2048);
                    E.rss = RSS + (size_t)i * NTOK; }
                else { g.A = PROJ; g.K = 2816; g.Bt = W + WO_2 + (size_t)i * 1024 * 2816; E.rss = nullptr; }
                g.N = 1024; g.M = NPR; SO.init(NPR, 1024, G, bid);
                if (s == 4 && !even) {
                    gss = (const u64*)(p.ws + WS_RSS) + 8 * (size_t)NTOK + (size_t)j * NTOK * 4;
                    pg8::Unit u0; LAS float* kr = (LAS float*)(lds_l + KR_OFF); const int tl = tid_opaque();
                    if (SO.next(0, u0) && tl < 256) { const size_t row = (size_t)u0.pm * 256 + tl; float r[4];
#pragma unroll
                        for (int q = 0; q < 4; ++q) r[q] = rsqrtf((float)gss[(size_t)q * NTOK + row] * (FXI / 512.f) + EPSN);
                        kr[tl * 4 + 0] = r[0] / r[1]; kr[tl * 4 + 1] = r[1] / r[2]; kr[tl * 4 + 2] = r[2] / r[3]; kr[tl * 4 + 3] = r[3]; }
                    __syncthreads();
                    E.kr = kr;
                }
                pg8::gemm_phase<EpiResid>(lds_l, g, SO, E);
                { EpiSResid ES; ES.XH = XH; ES.rss = E.rss;
                  for (int tile = bid; tile < 256; tile += G) sample_gemm<EpiSResid>(shm_l, g.A + (size_t)NPR * g.K, g.Bt, g.K, tile, ES, gss); }
            } else if (s == 5) {
                g.A = XH; g.Bt = W + WO_13 + (size_t)i * 5632 * 1024; g.N = 5632; g.K = 1024; SO.init(NTOK, 5632, G, bid);
                EpiSwiglu E; E.ACT = PROJ; E.rss = RSS + (size_t)i * NTOK;
                pg8::gemm_phase<EpiSwiglu>(lds_l, g, SO, E);
            } else if (s == 7) {
                g.A = XH; g.Bt = W + WO_G + (size_t)i * 1024 * 1024; g.N = 1024; g.K = 1024; g.M = NPR; SO.init(NPR, 1024, G, bid);
                EpiPle E; E.XH = XH; E.EB = EB; E.rss = RSS + (size_t)(4 + i) * NTOK; E.rsn = RSS + RSSN_OFF + (size_t)(i + 1) * NTOK; E.gp = p.in[I_GPLE] + (size_t)i * 1024;
                E.cnt = (unsigned*)(RSS + CNT_OFF) + i * 128;
                pg8::gemm_phase<EpiPle>(lds_l, g, SO, E);
                { EpiSPle ES; ES.XH = XH; ES.EB = EB; ES.rss = E.rss; ES.rsn = E.rsn; ES.gp = E.gp; ES.cnt = E.cnt;
                  for (int tile = bid; tile < 256; tile += G) sample_gemm<EpiSPle>(shm_l, g.A + (size_t)NPR * g.K, g.Bt, g.K, tile, ES); }
            } else if (i == 3) phase_final(p);
        }
        if (ph > 0 && ((ph - 1) % NPH_PER_LAYER == 3 || ((ph - 1) % NPH_PER_LAYER == 8 && ph + 1 < NPHASES))) continue;
        if (ph + 1 < ph_hi) { if (ph == ph_lo) { grid.sync(); xb = xcd_barrier_post(bar, st, gridDim.x); if (blockIdx.x >= 32) xb2 = xcd_barrier_post(bar + XCD_BAR_WORDS, st + 2, gridDim.x - 32); } else xcd_barrier(xb); }
    }
}

extern "C" void kernel_launch(void* const* d_in, const int* in_sizes, int n_in, void* d_out, int out_size, void* d_ws, size_t ws_size, hipStream_t stream) {
    static int grid = 0;
    if (grid == 0) {
        if (n_in != N_IN || (size_t)out_size != OO_END || ws_size < WS_END) { fprintf(stderr, "kernel_launch: unexpected shapes: n_in %d out %d ws %zu (need %zu)\n", n_in, out_size, ws_size, (size_t)WS_END); grid = -1; return; }
        int dev = 0, cus = 0, per_cu = 0;
        (void)hipGetDevice(&dev); (void)hipDeviceGetAttribute(&cus, hipDeviceAttributeMultiprocessorCount, dev);
        if (hipFuncSetAttribute((const void*)mega, hipFuncAttributeMaxDynamicSharedMemorySize, LDS_BYTES) != hipSuccess) { fprintf(stderr, "kernel_launch: hipFuncSetAttribute failed\n"); grid = -1; return; }
        if (hipOccupancyMaxActiveBlocksPerMultiprocessor(&per_cu, (const void*)mega, 512, LDS_BYTES) != hipSuccess || per_cu < 1) { fprintf(stderr, "kernel_launch: occupancy query failed (%d)\n", per_cu); (void)hipGetLastError(); per_cu = 1; }
        grid = cus * 1;
    }
    if (grid < 0) return;
    Params P; memset(&P, 0, sizeof(P));
    for (int i = 0; i < N_IN; ++i) P.in[i] = (const float*)d_in[i];
    P.out = (float*)d_out; P.ws = (unsigned char*)d_ws;
    P.ph_lo = 0; P.ph_hi = NPHASES;
    void* args[] = {&P};
    hipError_t e = hipLaunchCooperativeKernel((const void*)mega, dim3(grid), dim3(512), args, LDS_BYTES, stream);
    if (e != hipSuccess) fprintf(stderr, "kernel_launch: cooperative launch failed: %s (grid %d)\n", hipGetErrorString(e), grid);
}
```

```cpp
#include <hip/hip_runtime.h>
#include <hip/hip_cooperative_groups.h>
#include <cstdio>
#include <cstring>
namespace cg = cooperative_groups;

#define LAS __attribute__((address_space(3)))
typedef unsigned short bf16_t;
typedef short bf16x8 __attribute__((ext_vector_type(8)));
typedef float f32x4 __attribute__((ext_vector_type(4)));
typedef unsigned u32x4 __attribute__((ext_vector_type(4)));
typedef unsigned u32x2 __attribute__((ext_vector_type(2)));

constexpr int NTOK = 17408, NPR = 16384, DM = 1024, NSEQ = 136;
constexpr int KR_OFF = 131072 + 16;
constexpr int LDS_BYTES = 131072 + 16 + 4096;
constexpr float EPSN = 1e-6f;
constexpr int NPH_PER_LAYER = 9, NPHASES = 1 + 4 * NPH_PER_LAYER;

constexpr size_t WO_EIN = 0;
constexpr size_t WO_EOUT = WO_EIN + 2ull * 3072 * 1024;
constexpr size_t WO_SIN = WO_EOUT + 2ull * 1024 * 1024;
constexpr size_t WO_SOUT = WO_SIN + 2ull * 5376 * 1024;
constexpr size_t WO_13 = WO_SOUT + 2ull * 1024 * 2048;
constexpr size_t WO_2 = WO_13 + 4ull * 5632 * 1024;
constexpr size_t WO_G = WO_2 + 4ull * 1024 * 2816;
constexpr size_t WO_U = WO_G + 4ull * 1024 * 1024;
constexpr size_t WO_LRU = WO_U + 4ull * 1024 * 256;
constexpr size_t WO_END = WO_LRU + 2ull * 1024 * 512;

constexpr size_t al(size_t x) { return (x + 4095) & ~(size_t)4095; }
constexpr size_t WS_W = 0;
constexpr size_t WS_X = al(WS_W + WO_END * 2);
constexpr size_t WS_XN = al(WS_X + (size_t)NTOK * 4);
constexpr size_t WS_XB1 = al(WS_XN + (size_t)NTOK * 1024 * 2);
constexpr size_t WS_XB2 = al(WS_XB1 + (size_t)NTOK * 1024 * 2);
constexpr size_t WS_EB = al(WS_XB2 + (size_t)NTOK * 1024 * 2);
constexpr size_t WS_T = al(WS_EB + (size_t)NTOK * 1024 * 2);
constexpr size_t WS_PB = al(WS_T + (size_t)NTOK * 1024 * 2);
constexpr size_t WS_PROJ = al(WS_PB + 4ull * NTOK * 256 * 2);
constexpr size_t WS_U = al(WS_PROJ + (size_t)NTOK * 5376 * 2);
constexpr size_t WS_O = al(WS_U + (size_t)NTOK * 3072 * 2);
constexpr size_t WS_ON = al(WS_O + (size_t)NTOK * 2048 * 2);
constexpr size_t WS_DT = al(WS_ON + (size_t)NTOK * 2048 * 2);
constexpr size_t WS_RSS = al(WS_DT + (size_t)NTOK * 32 * 4 * 2);
constexpr size_t RSS_FLOATS = (size_t)NTOK * 21 + 512;
constexpr size_t RSSN_OFF = (size_t)NTOK * 16, CNT_OFF = (size_t)NTOK * 21;
constexpr size_t WS_HP = al(WS_RSS + RSS_FLOATS * 8);
constexpr size_t HP_UNIT = 4 * 16384 + 1024;
constexpr size_t WS_BAR = al(WS_HP + 1024 * HP_UNIT);
constexpr size_t WS_END = al(WS_BAR + 2 * 3456 * 4);
typedef unsigned long long u64;
constexpr float FXS = 16777216.f, FXI = 1.f / 16777216.f;

constexpr size_t OO_Y = 0;
constexpr size_t OO_HGP = OO_Y + (size_t)NTOK * 1024;
constexpr size_t OO_HGS = OO_HGP + 2ull * 8 * 4 * 128 * 128;
constexpr size_t OO_LHP = OO_HGS + 2ull * 128 * 4 * 128 * 128;
constexpr size_t OO_LHS = OO_LHP + 2ull * 8 * 512;
constexpr size_t OO_LCP = OO_LHS + 2ull * 128 * 512;
constexpr size_t OO_LCS = OO_LCP + 2ull * 8 * 3 * 512;
constexpr size_t OO_SSP = OO_LCS + 2ull * 128 * 3 * 512;
constexpr size_t OO_SSS = OO_SSP + 2ull * 8 * 32 * 64 * 128;
constexpr size_t OO_SCP = OO_SSS + 2ull * 128 * 32 * 64 * 128;
constexpr size_t OO_SCS = OO_SCP + 2ull * 8 * 3 * 3072;
constexpr size_t OO_END = OO_SCS + 2ull * 128 * 3 * 3072;

enum { I_XP = 0, I_XS, I_SHG, I_SLH, I_SLC, I_SSM, I_SSC, I_PP, I_PS, I_GMIX, I_GFFN, I_GPLE, I_GFIN, I_WEIN, I_HLB, I_HGN, I_LCW, I_LCB, I_LWA, I_LBA, I_LWX, I_LBX,
       I_LAM, I_WEOUT, I_SIN, I_SCW, I_SCB, I_SDTB, I_SALOG, I_SD, I_SGN, I_SOUT, I_W1, I_W3, I_W2, I_PUP, I_PGATE, N_IN };

struct Params {
    const float* in[N_IN];
    float* out;
    unsigned char* ws;
    int ph_lo, ph_hi;
};
typedef const Params __attribute__((address_space(4))) KParams;

#define LDSBAR() do { asm volatile("s_waitcnt lgkmcnt(0)" ::: "memory"); __builtin_amdgcn_s_barrier(); asm volatile("" ::: "memory"); } while (0)
__device__ __forceinline__ int tid_opaque() { int t = threadIdx.x; asm volatile("" : "+v"(t)); return t; }
__device__ __forceinline__ int tid_opaque_dep(int dep) { int t = threadIdx.x; asm volatile("" : "+v"(t) : "s"(dep)); return t; }
__device__ __forceinline__ int bid_opaque() { int b = blockIdx.x; asm volatile("" : "+s"(b)); return b; }
__device__ __forceinline__ unsigned cvt_pk_bf16(float lo, float hi) { unsigned r; asm volatile("v_cvt_pk_bf16_f32 %0, %1, %2" : "=v"(r) : "v"(lo), "v"(hi)); return r; }
__device__ __forceinline__ bf16_t f2bf(float f) { unsigned u = __float_as_uint(f); u += 0x7fffu + ((u >> 16) & 1u); return (bf16_t)(u >> 16); }
__device__ __forceinline__ float bf2f(bf16_t h) { return __uint_as_float(((unsigned)h) << 16); }
__device__ __forceinline__ float bflo(unsigned w) { return __uint_as_float(w << 16); }
__device__ __forceinline__ float bfhi(unsigned w) { return __uint_as_float(w & 0xffff0000u); }
__device__ __forceinline__ float sigmoidf_(float x) { return __builtin_amdgcn_rcpf(1.f + __expf(-x)); }
__device__ __forceinline__ float siluf_(float x) { return x * sigmoidf_(x); }
__device__ __forceinline__ float geluf_(float x) { const float u = 0.7978845608028654f * (x + 0.044715f * x * x * x); const float t = 1.f - 2.f * __builtin_amdgcn_rcpf(__expf(2.f * u) + 1.f); return 0.5f * x * (1.f + t); }
__device__ __forceinline__ float softplusf_(float x) { return x > 20.f ? x : log1pf(__expf(x)); }
__device__ __forceinline__ float wave_sum(float v) {
#pragma unroll
    for (int o = 32; o > 0; o >>= 1) v += __shfl_xor(v, o);
    return v;
}


#define XB_TMO      128
#define XB_XCNT(j)  (256  + 64 * (j))
#define XB_XSUB(j)  (1280 + 64 * (j))
#define XB_XGEN(j)  (2304 + 64 * (j))
#define XB_TOP      3328
#define XB_TOPGEN   3392
#define XCD_BAR_WORDS 3456
#define XB_SPIN_CAP (1u << 22)
__device__ __forceinline__ unsigned xb_ld(unsigned* p)              { return __hip_atomic_load(p, __ATOMIC_RELAXED, __HIP_MEMORY_SCOPE_AGENT); }
__device__ __forceinline__ unsigned xb_add(unsigned* p, unsigned v) { return __hip_atomic_fetch_add(p, v, __ATOMIC_RELAXED, __HIP_MEMORY_SCOPE_AGENT); }
__device__ __forceinline__ unsigned xb_xcc_id() { return (unsigned)__builtin_amdgcn_s_getreg((3 << 11) | 20) & 0xFu; }
#define XB_SPIN(cond, bar) do { unsigned _sp = 0; while (cond) { __builtin_amdgcn_s_sleep(1); \
    if ((++_sp & 255u) == 0u) { if (xb_ld(&(bar)[XB_TMO])) break; if (_sp > XB_SPIN_CAP) { atomicAdd(&(bar)[XB_TMO], 1u); break; } } } } while (0)
struct XcdBarrier { unsigned* bar; unsigned x; volatile LAS unsigned* st; unsigned expect; };
__device__ __forceinline__ XcdBarrier xcd_barrier_post(unsigned* bar, volatile LAS unsigned* st, unsigned expect) {
    XcdBarrier b; b.bar = bar; b.x = xb_xcc_id(); b.st = st; b.expect = expect;
    if (threadIdx.x == 0) (void)xb_add(&bar[XB_XCNT(b.x)], 1u);
    return b;
}
__device__ __forceinline__ void xcd_barrier_complete(unsigned* bar, unsigned x, unsigned& nloc, unsigned& nx, unsigned G) {
    unsigned sum, cnt, mine, sp = 0u;
    for (;;) {
        sum = 0u; cnt = 0u; mine = 0u;
#pragma unroll
        for (unsigned j = 0; j < 16; ++j) { const unsigned c = xb_ld(&bar[XB_XCNT(j)]); sum += c; cnt += (c > 0u) ? 1u : 0u; mine = (j == x) ? c : mine; }
        if (sum == G) break;
        __builtin_amdgcn_s_sleep(1);
        if ((++sp & 255u) == 0u) { if (xb_ld(&bar[XB_TMO])) break; if (sp > XB_SPIN_CAP) { atomicAdd(&bar[XB_TMO], 1u); break; } }
    }
    nloc = mine > 0u ? mine : 1u; nx = cnt > 0u ? cnt : 1u;
}
__device__ __forceinline__ void xcd_barrier(const XcdBarrier& b) {
    asm volatile("s_waitcnt vmcnt(0)" ::: "memory");
    __syncthreads();
    if (threadIdx.x == 0) {
        unsigned* bar = b.bar;
        __builtin_amdgcn_s_waitcnt(0);
        unsigned nloc = b.st[0], nx = b.st[1];
        if (nloc == 0u) { xcd_barrier_complete(bar, b.x, nloc, nx, b.expect); b.st[0] = nloc; b.st[1] = nx; }
        const unsigned old = xb_add(&bar[XB_XSUB(b.x)], 1u);
        const unsigned gen = old / nloc;
        if (old + 1u == (gen + 1u) * nloc) {
            __builtin_amdgcn_fence(__ATOMIC_RELEASE, "agent");
            asm volatile("s_waitcnt vmcnt(0)" ::: "memory");
            const unsigned og = xb_add(&bar[XB_TOP], 1u);
            const unsigned tg = og / nx;
            if (og + 1u == (tg + 1u) * nx) xb_add(&bar[XB_TOPGEN], 1u);
            else XB_SPIN(xb_ld(&bar[XB_TOPGEN]) == tg, bar);
            __builtin_amdgcn_fence(__ATOMIC_ACQUIRE, "agent");
            xb_add(&bar[XB_XGEN(b.x)], 1u);
            asm volatile("s_waitcnt vmcnt(0)" ::: "memory");
        } else {
            XB_SPIN(xb_ld(&bar[XB_XGEN(b.x)]) == gen, bar);
            __builtin_amdgcn_fence(__ATOMIC_ACQUIRE, "agent");
            asm volatile("s_waitcnt vmcnt(0)" ::: "memory");
        }
    }
    __syncthreads();
}

namespace pg8 {
constexpr int BM = 256, BK = 64, HALF = 128, HTB = HALF * BK * 2, STAGE_BYTES = 8 * HTB, NXCD = 8, WGM = 8;
__host__ __device__ __forceinline__ int lds_byte(int r, int c) { const int st = (r >> 4) * 2 + (c >> 5), rr = r & 15, cc = c & 31, ob = rr * 64 + cc * 2; return st * 1024 + (ob ^ (((ob >> 9) & 1) << 5)); }
__host__ __device__ __forceinline__ void stage_rc(int b, int& R, int& C) { const int st = b / 1024, sb = b % 1024, swz = sb ^ (((sb >> 9) & 1) << 5); R = (st >> 1) * 16 + swz / 64; C = (st & 1) * 32 + (swz % 64) / 2; }
__host__ __device__ __forceinline__ int perm32(int rho) { const int n = rho >> 4, i = rho & 15; return 8 * (i >> 2) + 4 * n + (i & 3); }
struct Unit { int pm, pn; };
struct Gemm { const bf16_t* A; const bf16_t* Bt; int M, N, K; };
struct StaticOrder {
    int nM, nN, nwg, G, c;
    __device__ void init(int M, int N, int G_, int c_) { nM = M / BM; nN = N / BM; nwg = nM * nN; G = G_; c = c_; }
    __device__ bool next(int i, Unit& u) const {
        const long L = (long)i * G + c; if (L >= nwg) return false;
        int wgid = (int)L; { const int q = nwg / NXCD, r = nwg % NXCD, xcd = wgid % NXCD, off = wgid / NXCD; wgid = (xcd < r ? xcd * (q + 1) : r * (q + 1) + (xcd - r) * q) + off; }
        const int nig = WGM * nN, gid = wgid / nig, fm = gid * WGM, gsz = (nM - fm) < WGM ? (nM - fm) : WGM;
        u.pm = fm + ((wgid % nig) % gsz); u.pn = (wgid % nig) / gsz; return true;
    }
};

template <class Epi>
__device__ __forceinline__ void gemm_phase(LAS unsigned char* lds, const Gemm g, const StaticOrder& S, const Epi& E) {
    const int tid = tid_opaque(), wid = __builtin_amdgcn_readfirstlane(tid >> 6), lane = tid & 63, wr = wid >> 2, wc = wid & 3, fr = lane & 15, fq = lane >> 4;
    const int K = g.K, nt = K / BK;
    unsigned voffA[2], voffB[2];
#pragma unroll
    for (int i = 0; i < 2; ++i) { int R, C; stage_rc(tid * 16 + i * 8192, R, C); const int Rb = Epi::PERM ? ((R & ~31) + perm32(R & 31)) : R;
        voffA[i] = (unsigned)(R * K + C) * 2u; voffB[i] = (unsigned)(Rb * K + C) * 2u; }
    const size_t kstep = (size_t)(BK * 2);
    const size_t hstep = (size_t)HALF * K * 2;
    const size_t tstep = 2 * hstep;
    const unsigned ldsw = (unsigned)wid * 1024u;
    const int aoff = lds_byte(wr * 64 + fr, fq * 8), boff = lds_byte(wc * 32 + fr, fq * 8);
#define PG8_SA(b, h) (((b) * 2 + (h)) * HTB)
#define PG8_SB(b, h) ((4 + (b) * 2 + (h)) * HTB)
#define PG8_STAGE(bufoff, gbase, voff) do { _Pragma("unroll") for (int _i = 0; _i < 2; ++_i) \
        __builtin_amdgcn_global_load_lds((const unsigned*)((const char*)(gbase) + (voff)[_i]), (LAS unsigned*)(lds + (bufoff) + ldsw + _i * 8192), 16, 0, 0); } while (0)
#define PG8_LDA(dst, b, h) do { _Pragma("unroll") for (int m = 0; m < 4; ++m) _Pragma("unroll") for (int k = 0; k < 2; ++k) dst[m][k] = *(const LAS bf16x8*)(lds + PG8_SA(b, h) + aoff + m * 2048 + k * 1024); } while (0)
#define PG8_LDB(dst, b, h) do { _Pragma("unroll") for (int n = 0; n < 2; ++n) _Pragma("unroll") for (int k = 0; k < 2; ++k) dst[n][k] = *(const LAS bf16x8*)(lds + PG8_SB(b, h) + boff + n * 2048 + k * 1024); } while (0)
#define PG8_MMA(ai, bj, At, Bt) do { __builtin_amdgcn_s_setprio(1); _Pragma("unroll") for (int m = 0; m < 4; ++m) _Pragma("unroll") for (int n = 0; n < 2; ++n) _Pragma("unroll") for (int k = 0; k < 2; ++k) \
        acc[ai][bj][m][n] = __builtin_amdgcn_mfma_f32_16x16x32_bf16(Bt[n][k], At[m][k], acc[ai][bj][m][n], 0, 0, 0); __builtin_amdgcn_s_setprio(0); } while (0)
#define PG8_WAIT_V(n) asm volatile("s_waitcnt vmcnt(" #n ")" ::: "memory")
#define PG8_WAIT_L(n) asm volatile("s_waitcnt lgkmcnt(" #n ")" ::: "memory")
#define PG8_BAR __builtin_amdgcn_s_barrier()
#define PG8_SCHED __builtin_amdgcn_sched_barrier(0)
    Unit cur, nxt; int ui = 0;
    if (!S.next(0, cur)) return;
    f32x4 acc[2][2][4][2];
#pragma unroll
    for (int a = 0; a < 2; ++a)
#pragma unroll
        for (int b = 0; b < 2; ++b)
#pragma unroll
            for (int m = 0; m < 4; ++m)
#pragma unroll
                for (int n = 0; n < 2; ++n) acc[a][b][m][n] = (f32x4){0.f, 0.f, 0.f, 0.f};
    bf16x8 At[4][2], B0[2][2], B1[2][2];
    const char* cA = (const char*)g.A + (size_t)cur.pm * tstep; const char* cB = (const char*)g.Bt + (size_t)cur.pn * tstep;
    PG8_STAGE(PG8_SB(0, 0), cB, voffB); PG8_STAGE(PG8_SA(0, 0), cA, voffA); PG8_STAGE(PG8_SB(0, 1), cB + hstep, voffB); PG8_STAGE(PG8_SA(0, 1), cA + hstep, voffA);
    if (wr == 1) PG8_BAR;
    PG8_WAIT_V(4); PG8_BAR;
    PG8_STAGE(PG8_SB(1, 0), cB + kstep, voffB); PG8_STAGE(PG8_SA(1, 0), cA + kstep, voffA); PG8_STAGE(PG8_SB(1, 1), cB + hstep + kstep, voffB);
    PG8_WAIT_V(6); PG8_BAR;
    for (;;) {
        const bool has_next = S.next(ui + 1, nxt);
        const char* nA = has_next ? (const char*)g.A + (size_t)nxt.pm * tstep : cA; const char* nB = has_next ? (const char*)g.Bt + (size_t)nxt.pn * tstep : cB;
        int tseg = nt; if constexpr (Epi::KSCALE) { if (E.kr) tseg = 8; }
        for (int t0 = 0; t0 < nt; t0 += tseg) {
        if (Epi::KSCALE && t0 > 0) {
            const unsigned kaddr = (unsigned)(size_t)lds + (unsigned)KR_OFF + (unsigned)((wr * 64 + fr) * 16 + ((t0 >> 3) - 1) * 4);
#define PG8_KS(a_, m_) do { float rr_; asm volatile("ds_read_b32 %0, %1 offset:%2\n\ts_waitcnt lgkmcnt(0)" : "=v"(rr_) : "v"(kaddr), "n"(((a_) * 128 + (m_) * 16) * 16) : "memory"); \
                acc[a_][0][m_][0] = acc[a_][0][m_][0] * rr_; acc[a_][0][m_][1] = acc[a_][0][m_][1] * rr_; acc[a_][1][m_][0] = acc[a_][1][m_][0] * rr_; acc[a_][1][m_][1] = acc[a_][1][m_][1] * rr_; } while (0)
            PG8_KS(0, 0); PG8_KS(0, 1); PG8_KS(0, 2); PG8_KS(0, 3); PG8_KS(1, 0); PG8_KS(1, 1); PG8_KS(1, 2); PG8_KS(1, 3);
#undef PG8_KS
        }
        for (int t = t0; t < t0 + tseg; t += 2) {
            const bool last = (t == nt - 2);
            const char* a1 = cA + (size_t)(t + 1) * kstep;
            const char* a2 = last ? nA : cA + (size_t)(t + 2) * kstep; const char* b2 = last ? nB : cB + (size_t)(t + 2) * kstep;
            const char* a3 = a2 + kstep; const char* b3 = b2 + kstep;
            PG8_LDB(B0, 0, 0); PG8_SCHED; PG8_LDA(At, 0, 0); PG8_STAGE(PG8_SA(1, 1), a1 + hstep, voffA);
            PG8_WAIT_L(8); PG8_BAR; PG8_WAIT_L(0); PG8_MMA(0, 0, At, B0); PG8_BAR; PG8_SCHED;
            PG8_LDB(B1, 0, 1); PG8_STAGE(PG8_SB(0, 0), b2, voffB);
            PG8_BAR; PG8_WAIT_L(0); PG8_MMA(0, 1, At, B1); PG8_BAR;
            PG8_LDA(At, 0, 1); PG8_STAGE(PG8_SA(0, 0), a2, voffA);
            PG8_BAR; PG8_WAIT_L(0); PG8_MMA(1, 0, At, B0); PG8_BAR; PG8_SCHED;
            PG8_STAGE(PG8_SB(0, 1), b2 + hstep, voffB);
            PG8_WAIT_V(6); PG8_BAR; PG8_MMA(1, 1, At, B1); PG8_BAR;
            PG8_LDB(B0, 1, 0); PG8_SCHED; PG8_LDA(At, 1, 0); PG8_STAGE(PG8_SA(0, 1), a2 + hstep, voffA);
            PG8_WAIT_L(8); PG8_BAR; PG8_WAIT_L(0); PG8_MMA(0, 0, At, B0); PG8_BAR; PG8_SCHED;
            PG8_LDB(B1, 1, 1); PG8_STAGE(PG8_SB(1, 0), b3, voffB);
            PG8_BAR; PG8_WAIT_L(0); PG8_MMA(0, 1, At, B1); PG8_BAR;
            PG8_LDA(At, 1, 1); PG8_STAGE(PG8_SA(1, 0), a3, voffA);
            PG8_BAR; PG8_WAIT_L(0); PG8_MMA(1, 0, At, B0); PG8_BAR; PG8_SCHED;
            PG8_STAGE(PG8_SB(1, 1), b3 + hstep, voffB);
            PG8_WAIT_V(6); PG8_BAR; PG8_MMA(1, 1, At, B1); PG8_BAR;
        }
        }
        if constexpr (!Epi::AFTER_DRAIN) E(acc, cur, wr, wc, fr, fq);
        if (!has_next) break;
#pragma unroll
        for (int a = 0; a < 2; ++a)
#pragma unroll
            for (int b = 0; b < 2; ++b)
#pragma unroll
                for (int m = 0; m < 4; ++m)
#pragma unroll
                    for (int n = 0; n < 2; ++n) acc[a][b][m][n] = (f32x4){0.f, 0.f, 0.f, 0.f};
        cur = nxt; cA = nA; cB = nB; ++ui;
    }
    PG8_WAIT_V(0);
    if (wr == 0) PG8_BAR;
    PG8_BAR;
    if constexpr (Epi::AFTER_DRAIN) E.fused(acc, cur, wr, wc, fr, fq);
#undef PG8_SA
#undef PG8_SB
#undef PG8_STAGE
#undef PG8_LDA
#undef PG8_LDB
#undef PG8_MMA
#undef PG8_WAIT_V
#undef PG8_WAIT_L
#undef PG8_BAR
#undef PG8_SCHED
}
}

struct EpiStore {
    static constexpr bool AFTER_DRAIN = false;
    static constexpr bool KSCALE = false;
    static constexpr bool PERM = true;
    bf16_t* O; int ldc; const u64* rs0;
    __device__ __forceinline__ void operator()(const f32x4 (&acc)[2][2][4][2], const pg8::Unit& u, int wr, int wc, int fr, int fq) const {
        const int row0 = u.pm * 256 + wr * 64 + fr, col0 = u.pn * 256 + wc * 32 + 8 * fq;
#pragma unroll
        for (int ai = 0; ai < 2; ++ai)
#pragma unroll
            for (int m = 0; m < 4; ++m) { bf16_t* rowp = O + (size_t)(row0 + ai * 128 + m * 16) * ldc + col0;
                const float r = rs0 ? rsqrtf((float)rs0[row0 + ai * 128 + m * 16] * (FXI / 1024.f) + EPSN) : 1.f;
#pragma unroll
                for (int bj = 0; bj < 2; ++bj) { const f32x4 v0 = acc[ai][bj][m][0] * r, v1 = acc[ai][bj][m][1] * r;
                    u32x4 w; w[0] = cvt_pk_bf16(v0[0], v0[1]); w[1] = cvt_pk_bf16(v0[2], v0[3]); w[2] = cvt_pk_bf16(v1[0], v1[1]); w[3] = cvt_pk_bf16(v1[2], v1[3]);
                    *(u32x4*)(rowp + bj * 128) = w; } }
    }
};
struct EpiResid {
    static constexpr bool AFTER_DRAIN = false;
    static constexpr bool PERM = true, KSCALE = true;
    bf16_t* XH; u64* rss; const LAS float* kr;
    __device__ __forceinline__ void operator()(const f32x4 (&acc)[2][2][4][2], const pg8::Unit& u, int wr, int wc, int fr, int fq) const {
        const int row0 = u.pm * 256 + wr * 64 + fr, col0 = u.pn * 256 + wc * 32 + 8 * fq;
#pragma unroll
        for (int ai = 0; ai < 2; ++ai)
#pragma unroll
            for (int m = 0; m < 4; ++m) { const int row = row0 + ai * 128 + m * 16; float ss = 0.f;
                const float rl = kr ? kr[(ai * 128 + wr * 64 + m * 16 + fr) * 4 + 3] : 1.f;
#pragma unroll
                for (int bj = 0; bj < 2; ++bj) { bf16_t* xp = XH + (size_t)row * 1024 + col0 + bj * 128; const u32x4 xw = *(const u32x4*)xp; u32x4 w;
#pragma unroll
                    for (int n = 0; n < 2; ++n) { const f32x4 a = acc[ai][bj][m][n] * rl;
                        const float x0 = bflo(xw[2 * n]) + a[0], x1 = bfhi(xw[2 * n]) + a[1], x2 = bflo(xw[2 * n + 1]) + a[2], x3 = bfhi(xw[2 * n + 1]) + a[3];
                        ss += x0 * x0 + x1 * x1 + x2 * x2 + x3 * x3; w[2 * n] = cvt_pk_bf16(x0, x1); w[2 * n + 1] = cvt_pk_bf16(x2, x3); }
                    *(u32x4*)xp = w; }
                if (rss) { ss += __shfl_xor(ss, 16); ss += __shfl_xor(ss, 32); if (fq == 0) atomicAdd(rss + row, (u64)(ss * FXS)); } }
    }
};
struct EpiSwiglu {
    static constexpr bool AFTER_DRAIN = false;
    static constexpr bool KSCALE = false;
    static constexpr bool PERM = true;
    bf16_t* ACT; const u64* rss;
    __device__ __forceinline__ void operator()(const f32x4 (&acc)[2][2][4][2], const pg8::Unit& u, int wr, int wc, int fr, int fq) const {
        const int row0 = u.pm * 256 + wr * 64 + fr, col0 = u.pn * 128 + wc * 32 + 8 * fq;
#pragma unroll
        for (int ai = 0; ai < 2; ++ai)
#pragma unroll
            for (int m = 0; m < 4; ++m) { const int row = row0 + ai * 128 + m * 16;
                const float r = rsqrtf((float)rss[row] * (FXI / 1024.f) + EPSN), r2 = r * r, rl = -1.44269504f * r;
                u32x4 w;
#pragma unroll
                for (int n = 0; n < 2; ++n) { const f32x4 a1 = acc[ai][0][m][n], a3 = acc[ai][1][m][n]; float o[4];
#pragma unroll
                    for (int q = 0; q < 4; ++q) o[q] = (a1[q] * a3[q]) * (r2 * __builtin_amdgcn_rcpf(1.f + __builtin_amdgcn_exp2f(a1[q] * rl)));
                    w[2 * n] = cvt_pk_bf16(o[0], o[1]); w[2 * n + 1] = cvt_pk_bf16(o[2], o[3]); }
                *(u32x4*)(ACT + (size_t)row * 2816 + col0) = w; }
    }
};
__device__ __forceinline__ void panel_wait(unsigned* cnt, unsigned need) {
    asm volatile("s_waitcnt vmcnt(0)" ::: "memory");
    __syncthreads();
    if (threadIdx.x == 0) { (void)xb_add(cnt, 1u); unsigned sp = 0u; while (xb_ld(cnt) < need) { __builtin_amdgcn_s_sleep(1); if (++sp > (1u << 22)) break; } }
    __syncthreads();
}
struct EpiPle {
    static constexpr bool KSCALE = false, PERM = true, AFTER_DRAIN = true;
    bf16_t* XH; const bf16_t* EB; u64* rss; u64* rsn; const float* gp; unsigned* cnt;
    __device__ __forceinline__ void fused(f32x4 (&acc)[2][2][4][2], const pg8::Unit& u, int wr, int wc, int fr, int fq) const {
        const int row0 = u.pm * 256 + wr * 64 + fr, col0 = u.pn * 256 + wc * 32 + 8 * fq;
#pragma unroll
        for (int ai = 0; ai < 2; ++ai)
#pragma unroll
            for (int m = 0; m < 4; ++m) { const int row = row0 + ai * 128 + m * 16; float ss = 0.f;
#pragma unroll
                for (int bj = 0; bj < 2; ++bj) { const u32x4 e = *(const u32x4*)(EB + (size_t)row * 1024 + col0 + bj * 128);
#pragma unroll
                    for (int n = 0; n < 2; ++n) { f32x4 v = acc[ai][bj][m][n];
                        v[0] = sigmoidf_(v[0]) * bflo(e[2 * n]); v[1] = sigmoidf_(v[1]) * bfhi(e[2 * n]); v[2] = sigmoidf_(v[2]) * bflo(e[2 * n + 1]); v[3] = sigmoidf_(v[3]) * bfhi(e[2 * n + 1]);
                        ss += v[0] * v[0] + v[1] * v[1] + v[2] * v[2] + v[3] * v[3]; acc[ai][bj][m][n] = v; } }
                ss += __shfl_xor(ss, 16); ss += __shfl_xor(ss, 32); if (fq == 0) atomicAdd(rss + row, (u64)(ss * FXS)); }
        panel_wait(cnt + u.pm, 4u);
#pragma unroll
        for (int ai = 0; ai < 2; ++ai)
#pragma unroll
            for (int m = 0; m < 4; ++m) { const int row = row0 + ai * 128 + m * 16; float ss = 0.f;
                const float rt = rsqrtf((float)__hip_atomic_load(rss + row, __ATOMIC_RELAXED, __HIP_MEMORY_SCOPE_AGENT) * (FXI / 1024.f) + EPSN);
#pragma unroll
                for (int bj = 0; bj < 2; ++bj) { bf16_t* xp = XH + (size_t)row * 1024 + col0 + bj * 128; const u32x4 xw = *(const u32x4*)xp; u32x4 w;
#pragma unroll
                    for (int n = 0; n < 2; ++n) { const f32x4 t = acc[ai][bj][m][n], gg = *(const f32x4*)(gp + col0 + bj * 128 + 4 * n);
                        const float x0 = bflo(xw[2 * n]) + t[0] * rt * gg[0], x1 = bfhi(xw[2 * n]) + t[1] * rt * gg[1], x2 = bflo(xw[2 * n + 1]) + t[2] * rt * gg[2], x3 = bfhi(xw[2 * n + 1]) + t[3] * rt * gg[3];
                        ss += x0 * x0 + x1 * x1 + x2 * x2 + x3 * x3; w[2 * n] = cvt_pk_bf16(x0, x1); w[2 * n + 1] = cvt_pk_bf16(x2, x3); }
                    *(u32x4*)xp = w; }
                ss += __shfl_xor(ss, 16); ss += __shfl_xor(ss, 32); if (fq == 0) atomicAdd(rsn + row, (u64)(ss * FXS)); }
    }
};
struct EpiLru {
    static constexpr bool AFTER_DRAIN = false;
    static constexpr bool KSCALE = false;
    static constexpr bool PERM = false;
    float* LA; float* LBT; const bf16_t* U; const float* ba; const float* bx; const float* lam;
    __device__ __forceinline__ void operator()(const f32x4 (&acc)[2][2][4][2], const pg8::Unit& u, int wr, int wc, int fr, int fq) const {
        const int row0 = u.pm * 256 + wr * 64 + fr, ch0 = u.pn * 128 + wc * 32 + 4 * fq;
#pragma unroll
        for (int n = 0; n < 2; ++n) { const int ch = ch0 + n * 16;
            const f32x4 bav = *(const f32x4*)(ba + ch), bxv = *(const f32x4*)(bx + ch), lmv = *(const f32x4*)(lam + ch);
            f32x4 sp;
#pragma unroll
            for (int q = 0; q < 4; ++q) sp[q] = -8.f * softplusf_(-lmv[q]);
#pragma unroll
            for (int ai = 0; ai < 2; ++ai)
#pragma unroll
                for (int m = 0; m < 4; ++m) { const int row = row0 + ai * 128 + m * 16;
                    const bool first = (row < NPR) && ((row & 2047) == 0);
                    const u32x2 uw = *(const u32x2*)(U + (size_t)row * 512 + ch);
                    const float uu[4] = {bflo(uw[0]), bfhi(uw[0]), bflo(uw[1]), bfhi(uw[1])};
                    f32x4 av, bv;
#pragma unroll
                    for (int q = 0; q < 4; ++q) { const float r = sigmoidf_(acc[ai][0][m][n][q] + bav[q]), gi = sigmoidf_(acc[ai][1][m][n][q] + bxv[q]);
                        const float la = sp[q] * r; av[q] = __expf(la); const float x2 = 2.f * la;
                        const float em = x2 > -0.25f ? -x2 * (1.f + x2 * (0.5f + x2 * (0.16666667f + x2 * (0.041666668f + x2 * 0.0083333338f)))) : 1.f - __expf(x2);
                        const float mult = first ? 1.f : __builtin_amdgcn_sqrtf(em); bv[q] = mult * gi * uu[q]; }
                    *(f32x4*)(LA + (size_t)row * 512 + ch) = av; *(f32x4*)(LBT + (size_t)row * 512 + ch) = bv; }
        }
    }
};


template <class EpiS>
__device__ __forceinline__ void sample_gemm(unsigned char* shm, const bf16_t* A, const bf16_t* Bt, int K, int tile, const EpiS& E, const u64* gss = nullptr) {
    const int tid = tid_opaque(), lane = tid & 63, wid = tid >> 6, fr = lane & 15, fq = lane >> 4, wr = wid >> 2, wc = wid & 3;
    const int tm = tile >> 4, tn = tile & 15;
    constexpr int PIT = 136;
    bf16_t* sA = (bf16_t*)shm; bf16_t* sB = sA + 2 * 64 * PIT;
    const int lrow = tid >> 3, lc8 = (tid & 7) * 8;
    const bf16_t* gA = A + (size_t)(tm * 64 + lrow) * K + lc8;
    const bf16_t* gB = Bt + (size_t)(tn * 64 + lrow) * K + lc8;
    f32x4 acc[2]; acc[0] = (f32x4){0.f, 0.f, 0.f, 0.f}; acc[1] = acc[0];
    u32x4 ra0 = *(const u32x4*)gA, ra1 = *(const u32x4*)(gA + 64), rb0 = *(const u32x4*)gB, rb1 = *(const u32x4*)(gB + 64);
    const int nk = K >> 7;
    LDSBAR();
    for (int kt = 0; kt < nk; ++kt) {
        bf16_t* bA = sA + (kt & 1) * 64 * PIT; bf16_t* bB = sB + (kt & 1) * 64 * PIT;
        *(u32x4*)(bA + lrow * PIT + lc8) = ra0; *(u32x4*)(bA + lrow * PIT + 64 + lc8) = ra1; *(u32x4*)(bB + lrow * PIT + lc8) = rb0; *(u32x4*)(bB + lrow * PIT + 64 + lc8) = rb1;
        LDSBAR();
        if (kt + 1 < nk) { const size_t o = (size_t)(kt + 1) * 128; ra0 = *(const u32x4*)(gA + o); ra1 = *(const u32x4*)(gA + o + 64); rb0 = *(const u32x4*)(gB + o); rb1 = *(const u32x4*)(gB + o + 64); }
        if (gss && kt > 0 && (kt & 3) == 0) { const int gi = (kt >> 2) - 1;
#pragma unroll
            for (int m = 0; m < 2; ++m) { const size_t row = NPR + tm * 64 + wr * 32 + m * 16 + fr;
                const float r0 = rsqrtf((float)gss[(size_t)gi * NTOK + row] * (FXI / 512.f) + EPSN), r1 = rsqrtf((float)gss[(size_t)(gi + 1) * NTOK + row] * (FXI / 512.f) + EPSN);
                acc[m] = acc[m] * (r0 / r1); } }
#pragma unroll
        for (int ks = 0; ks < 4; ++ks) { const bf16x8 bfg = *(const bf16x8*)(bB + (wc * 16 + fr) * PIT + ks * 32 + fq * 8);
#pragma unroll
            for (int m = 0; m < 2; ++m) acc[m] = __builtin_amdgcn_mfma_f32_16x16x32_bf16(bfg, *(const bf16x8*)(bA + (wr * 32 + m * 16 + fr) * PIT + ks * 32 + fq * 8), acc[m], 0, 0, 0); }
    }
    LDSBAR();
    if (gss) {
#pragma unroll
        for (int m = 0; m < 2; ++m) { const size_t row = NPR + tm * 64 + wr * 32 + m * 16 + fr; acc[m] = acc[m] * rsqrtf((float)gss[3 * (size_t)NTOK + row] * (FXI / 512.f) + EPSN); } }
    E(acc, NPR + tm * 64 + wr * 32 + fr, tn * 64 + wc * 16 + 4 * fq, fq);
}
struct EpiSResid {
    bf16_t* XH; u64* rss;
    __device__ __forceinline__ void operator()(const f32x4 (&acc)[2], int row0, int col0, int fq) const {
#pragma unroll
        for (int m = 0; m < 2; ++m) { const int row = row0 + m * 16; bf16_t* xp = XH + (size_t)row * 1024 + col0;
            const u32x2 xw = *(const u32x2*)xp;
            const float x0 = bflo(xw[0]) + acc[m][0], x1 = bfhi(xw[0]) + acc[m][1], x2 = bflo(xw[1]) + acc[m][2], x3 = bfhi(xw[1]) + acc[m][3];
            float ss = x0 * x0 + x1 * x1 + x2 * x2 + x3 * x3;
            u32x2 w; w[0] = cvt_pk_bf16(x0, x1); w[1] = cvt_pk_bf16(x2, x3); *(u32x2*)xp = w;
            if (rss) { ss += __shfl_xor(ss, 16); ss += __shfl_xor(ss, 32); if (fq == 0) atomicAdd(rss + row, (u64)(ss * FXS)); } }
    }
};
struct EpiSPle {
    bf16_t* XH; const bf16_t* EB; u64* rss; u64* rsn; const float* gp; unsigned* cnt;
    __device__ __forceinline__ void operator()(f32x4 (&acc)[2], int row0, int col0, int fq) const {
#pragma unroll
        for (int m = 0; m < 2; ++m) { const int row = row0 + m * 16; const u32x2 e = *(const u32x2*)(EB + (size_t)row * 1024 + col0);
            f32x4 v = acc[m];
            v[0] = sigmoidf_(v[0]) * bflo(e[0]); v[1] = sigmoidf_(v[1]) * bfhi(e[0]); v[2] = sigmoidf_(v[2]) * bflo(e[1]); v[3] = sigmoidf_(v[3]) * bfhi(e[1]);
            float ss = v[0] * v[0] + v[1] * v[1] + v[2] * v[2] + v[3] * v[3]; acc[m] = v;
            ss += __shfl_xor(ss, 16); ss += __shfl_xor(ss, 32); if (fq == 0) atomicAdd(rss + row, (u64)(ss * FXS)); }
        panel_wait(cnt + 64 + ((row0 - NPR) >> 6), 16u);
        const f32x4 gg = *(const f32x4*)(gp + col0);
#pragma unroll
        for (int m = 0; m < 2; ++m) { const int row = row0 + m * 16; bf16_t* xp = XH + (size_t)row * 1024 + col0; const u32x2 xw = *(const u32x2*)xp;
            const float rt = rsqrtf((float)__hip_atomic_load(rss + row, __ATOMIC_RELAXED, __HIP_MEMORY_SCOPE_AGENT) * (FXI / 1024.f) + EPSN);
            const f32x4 t = acc[m];
            const float x0 = bflo(xw[0]) + t[0] * rt * gg[0], x1 = bfhi(xw[0]) + t[1] * rt * gg[1], x2 = bflo(xw[1]) + t[2] * rt * gg[2], x3 = bfhi(xw[1]) + t[3] * rt * gg[3];
            float ss = x0 * x0 + x1 * x1 + x2 * x2 + x3 * x3;
            u32x2 w; w[0] = cvt_pk_bf16(x0, x1); w[1] = cvt_pk_bf16(x2, x3); *(u32x2*)xp = w;
            ss += __shfl_xor(ss, 16); ss += __shfl_xor(ss, 32); if (fq == 0) atomicAdd(rsn + row, (u64)(ss * FXS)); }
    }
};

__device__ __forceinline__ int seq_base(int s) { return s < 8 ? s * 2048 : NPR + (s - 8) * 8; }
__device__ __forceinline__ int seq_len(int s) { return s < 8 ? 2048 : 8; }

template <int LD_SRC, int K, int N, int LD_DST, int ROW_BLK, int ROW_BLK_STRIDE, int ROW_OFF, int NL, int START>
__device__ __forceinline__ void transpose_kind(const float* src0, bf16_t* dst0, size_t dst_stride, float* tile, const float* scale0 = nullptr, int sc_mul = 0, int sc_add = 0) {
    constexpr int NTN = (N + 63) / 64, PER = (K / 64) * NTN, TOT = PER * NL;
    const int tid = tid_opaque(), G = gridDim.x;
    const int first = ((bid_opaque() - START) % G + G) % G;
    f32x4 v[2];
#define TK_FETCH(tt) do { const int l_ = (tt) / PER, lt_ = (tt) % PER, k0_ = (lt_ / NTN) * 64, n0_ = (lt_ % NTN) * 64; const float* src_ = src0 + (size_t)l_ * K * LD_SRC; \
        _Pragma("unroll") for (int i = 0; i < 2; ++i) { const int idx = tid + i * 512, r = idx >> 4, c4 = (idx & 15) * 4; v[i] = (f32x4){0.f, 0.f, 0.f, 0.f}; \
            if (n0_ + c4 < N) v[i] = *(const f32x4*)(src_ + (size_t)(k0_ + r) * LD_SRC + n0_ + c4); } } while (0)
    if (first < TOT) TK_FETCH(first);
    for (int t = first; t < TOT; t += G) {
        const int l = t / PER, lt = t % PER, kt = lt / NTN, ntile = lt % NTN, k0 = kt * 64, n0 = ntile * 64;
        bf16_t* dst = dst0 + (size_t)l * dst_stride;
        LDSBAR();
#pragma unroll
        for (int i = 0; i < 2; ++i) { const int idx = tid + i * 512, r = idx >> 4, c4 = (idx & 15) * 4;
            tile[r * 65 + c4] = v[i][0]; tile[r * 65 + c4 + 1] = v[i][1]; tile[r * 65 + c4 + 2] = v[i][2]; tile[r * 65 + c4 + 3] = v[i][3]; }
        LDSBAR();
        if (t + G < TOT) TK_FETCH(t + G);
#pragma unroll
        for (int i = 0; i < 4; ++i) { const int idx = tid + i * 512, r = idx >> 5, c2 = (idx & 31) * 2, n = n0 + r;
            if (n < N) { const int drow = (n / ROW_BLK) * ROW_BLK_STRIDE + (n % ROW_BLK) + ROW_OFF;
                float sa = 1.f, sb = 1.f; if (scale0) { const float* sc = scale0 + (size_t)(l * sc_mul + sc_add) * 1024 + k0 + c2; sa = sc[0]; sb = sc[1]; }
                *(unsigned*)(dst + (size_t)drow * LD_DST + k0 + c2) = cvt_pk_bf16(tile[c2 * 65 + r] * sa, tile[(c2 + 1) * 65 + r] * sb); } }
    }
#undef TK_FETCH
    LDSBAR();
}
__device__ void phase_init(KParams& p, unsigned char* shm) {
    const int tid = tid_opaque(), G = gridDim.x, bid = bid_opaque();
    float* tile = (float*)shm;
    {
        bf16_t* Wt = (bf16_t*)(p.ws + WS_W);
        constexpr int T0 = 0, T1 = T0 + 2 * 16 * 48, T2 = T1 + 2 * 16 * 16, T3 = T2 + 2 * 16 * 81, T4 = T3 + 2 * 32 * 16, T5 = T4 + 4 * 16 * 44, T6 = T5 + 4 * 16 * 44, T7 = T6 + 4 * 44 * 16, T8 = T7 + 4 * 16 * 16;
        transpose_kind<3072, 1024, 3072, 1024, 3072, 3072, 0, 2, T0>(p.in[I_WEIN], Wt + WO_EIN, 3072ull * 1024, tile, p.in[I_GMIX], 2, 0);
        transpose_kind<1024, 1024, 1024, 1024, 1024, 1024, 0, 2, T1>(p.in[I_WEOUT], Wt + WO_EOUT, 1024ull * 1024, tile);
        transpose_kind<5152, 1024, 5152, 1024, 5152, 5152, 0, 2, T2>(p.in[I_SIN], Wt + WO_SIN, 5376ull * 1024, tile, p.in[I_GMIX], 2, 1);
        transpose_kind<1024, 2048, 1024, 2048, 1024, 1024, 0, 2, T3>(p.in[I_SOUT], Wt + WO_SOUT, 1024ull * 2048, tile, p.in[I_SGN], 2, 0);
        transpose_kind<2816, 1024, 2816, 1024, 128, 256, 0, 4, T4>(p.in[I_W1], Wt + WO_13, 5632ull * 1024, tile, p.in[I_GFFN], 1, 0);
        transpose_kind<2816, 1024, 2816, 1024, 128, 256, 128, 4, T5>(p.in[I_W3], Wt + WO_13, 5632ull * 1024, tile, p.in[I_GFFN], 1, 0);
        transpose_kind<1024, 2816, 1024, 2816, 1024, 1024, 0, 4, T6>(p.in[I_W2], Wt + WO_2, 1024ull * 2816, tile);
        transpose_kind<1024, 1024, 1024, 1024, 1024, 1024, 0, 4, T7>(p.in[I_PGATE], Wt + WO_G, 1024ull * 1024, tile);
        transpose_kind<1024, 256, 1024, 256, 1024, 1024, 0, 4, T8>(p.in[I_PUP], Wt + WO_U, 1024ull * 256, tile);
    }
    bf16_t* W = (bf16_t*)(p.ws + WS_W);
    for (int idx0 = bid * 512 + tid; idx0 < 2 * 1024 * 512; idx0 += 4 * G * 512) { float vv[4];
#pragma unroll
        for (int q = 0; q < 4; ++q) { const int idx = idx0 + q * G * 512; vv[q] = 0.f;
            if (idx < 2 * 1024 * 512) { const int k = idx & 511, n = (idx >> 9) & 1023, j = idx >> 19, hb = n >> 8, gate = (n >> 7) & 1, c = n & 127;
                if ((k >> 7) == hb) { const float* gw = gate ? p.in[I_LWX] : p.in[I_LWA]; vv[q] = gw[(((size_t)j * 4 + hb) * 128 + (k & 127)) * 128 + c]; } } }
#pragma unroll
        for (int q = 0; q < 4; ++q) { const int idx = idx0 + q * G * 512; if (idx < 2 * 1024 * 512) W[WO_LRU + idx] = f2bf(vv[q]); }
    }
    u64* RSN0 = (u64*)(p.ws + WS_RSS) + RSSN_OFF; bf16_t* XH = (bf16_t*)(p.ws + WS_XN);
    const int wid = tid >> 6, lane = tid & 63;
    for (int row0 = bid * 8 + wid; row0 < NTOK; row0 += 2 * G * 8) { f32x4 xv[2][4];
#pragma unroll
        for (int k = 0; k < 2; ++k) { const int row = row0 + k * G * 8;
#pragma unroll
            for (int i = 0; i < 4; ++i) xv[k][i] = (f32x4){0.f, 0.f, 0.f, 0.f};
            if (row < NTOK) { const float* src = row < NPR ? p.in[I_XP] + (size_t)row * 1024 : p.in[I_XS] + (size_t)(row - NPR) * 1024;
#pragma unroll
                for (int i = 0; i < 4; ++i) xv[k][i] = *(const f32x4*)(src + i * 256 + lane * 4); } }
#pragma unroll
        for (int k = 0; k < 2; ++k) { const int row = row0 + k * G * 8;
            if (row < NTOK) { float ss = 0.f;
#pragma unroll
                for (int i = 0; i < 4; ++i) { const int c = i * 256 + lane * 4; const f32x4 v = xv[k][i]; ss += v[0] * v[0] + v[1] * v[1] + v[2] * v[2] + v[3] * v[3];
                    u32x2 w; w[0] = cvt_pk_bf16(v[0], v[1]); w[1] = cvt_pk_bf16(v[2], v[3]); *(u32x2*)(XH + (size_t)row * 1024 + c) = w; }
                ss = wave_sum(ss); if (lane == 0) RSN0[row] = (u64)(ss * FXS); } }
    }
    bf16_t* PB = (bf16_t*)(p.ws + WS_PB);
    { const size_t total = 4ull * NTOK * 64, stride = (size_t)G * 512;
      for (size_t idx0 = (size_t)bid * 512 + tid; idx0 < total; idx0 += 4 * stride) { f32x4 v[4];
#pragma unroll
        for (int k = 0; k < 4; ++k) { const size_t idx = idx0 + k * stride; v[k] = (f32x4){0.f, 0.f, 0.f, 0.f};
            if (idx < total) { const int c4 = (int)(idx & 63); const size_t rt = idx >> 6; const int tok = (int)(rt % NTOK), l = (int)(rt / NTOK);
                const float* src = tok < NPR ? p.in[I_PP] + ((size_t)l * NPR + tok) * 256 : p.in[I_PS] + ((size_t)l * 1024 + (tok - NPR)) * 256;
                v[k] = *(const f32x4*)(src + c4 * 4); } }
#pragma unroll
        for (int k = 0; k < 4; ++k) { const size_t idx = idx0 + k * stride;
            if (idx < total) { u32x2 w; w[0] = cvt_pk_bf16(v[k][0], v[k][1]); w[1] = cvt_pk_bf16(v[k][2], v[k][3]); *(u32x2*)(PB + (idx >> 6) * 256 + (idx & 63) * 4) = w; } } } }
    u64* RSS = (u64*)(p.ws + WS_RSS);
    for (size_t idx = (size_t)bid * 512 + tid; idx < RSS_FLOATS; idx += (size_t)G * 512) if (idx < RSSN_OFF || idx >= RSSN_OFF + NTOK) RSS[idx] = 0ull;
}

__device__ void phase_conv_lru(KParams& p, int j) {
    const bf16_t* PROJ = (const bf16_t*)(p.ws + WS_PROJ); bf16_t* U = (bf16_t*)(p.ws + WS_U);
    const float* cw = p.in[I_LCW] + (size_t)j * 4 * 512; const float* cb = p.in[I_LCB] + (size_t)j * 512;
    for (int idx = bid_opaque() * 512 + tid_opaque(); idx < NTOK * 64; idx += gridDim.x * 512) {
        const int row = idx >> 6, c8 = (idx & 63) * 8;
        int t, L, b; const bool pr = row < NPR;
        if (pr) { t = row & 2047; L = 2048; b = row >> 11; } else { t = (row - NPR) & 7; L = 8; b = (row - NPR) >> 3; }
        float o[8];
#pragma unroll
        for (int q = 0; q < 8; ++q) o[q] = cb[c8 + q];
        float last[8];
#pragma unroll
        for (int k = 0; k < 4; ++k) { const int m = t + k; float v[8];
            if (m >= 3) { const u32x4 w = *(const u32x4*)(PROJ + (size_t)(row + k - 3) * 3072 + 2560 + c8);
#pragma unroll
                for (int q = 0; q < 4; ++q) { v[2 * q] = bflo(w[q]); v[2 * q + 1] = bfhi(w[q]); } }
            else if (!pr) { const float* sp = p.in[I_SLC] + (((size_t)j * 128 + b) * 3 + m) * 512 + c8;
#pragma unroll
                for (int q = 0; q < 8; ++q) v[q] = sp[q]; }
            else {
#pragma unroll
                for (int q = 0; q < 8; ++q) v[q] = 0.f; }
#pragma unroll
            for (int q = 0; q < 8; ++q) { o[q] += cw[k * 512 + c8 + q] * v[q]; if (k == 3) last[q] = v[q]; } }
        u32x4 w;
#pragma unroll
        for (int q = 0; q < 4; ++q) w[q] = cvt_pk_bf16(o[2 * q], o[2 * q + 1]);
        *(u32x4*)(U + (size_t)row * 512 + c8) = w;
        if (t >= L - 3) { const int r = t - (L - 3);
            float* dst = pr ? p.out + OO_LCP + (((size_t)j * 8 + b) * 3 + r) * 512 + c8 : p.out + OO_LCS + (((size_t)j * 128 + b) * 3 + r) * 512 + c8;
#pragma unroll
            for (int q = 0; q < 8; ++q) dst[q] = last[q]; }
    }
}

__device__ void hgrn_unit(KParams& p, int j, int s, int h, unsigned char* shm) {
    const int tid = tid_opaque(), dv = tid & 127, dq = tid >> 7, wid = tid >> 6, lane = tid & 63;
    const bf16_t* PROJ = (const bf16_t*)(p.ws + WS_PROJ); bf16_t* O = (bf16_t*)(p.ws + WS_O);
    float* qs = (float*)shm; float* fs = qs + 16 * 128; float* ks = fs + 16 * 128; float* vs = ks + 16 * 128; float* op = vs + 16 * 128;
    const int base = seq_base(s), L = seq_len(s), nb = L < 16 ? L : 16;
    float S[32];
    if (s >= 8) { const float* s0 = p.in[I_SHG] + (((size_t)j * 128 + (s - 8)) * 4 + h) * 16384;
#pragma unroll
        for (int i = 0; i < 32; ++i) S[i] = s0[(dq * 32 + i) * 128 + dv]; }
    else {
#pragma unroll
        for (int i = 0; i < 32; ++i) S[i] = 0.f; }
    const float gn0 = p.in[I_HGN][j * 512 + h * 128 + lane], gn1 = p.in[I_HGN][j * 512 + h * 128 + lane + 64];
    for (int t0 = 0; t0 < L; t0 += nb) {
        LDSBAR();
        for (int idx = tid; idx < nb * 128; idx += 512) { const int t = idx >> 7, dk = idx & 127; const size_t ro = (size_t)(base + t0 + t) * 3072 + h * 128 + dk;
            const float q = bf2f(PROJ[ro]), fz = bf2f(PROJ[ro + 512]);
            float lb = 0.f;
            if (j == 1) lb = sigmoidf_(p.in[I_HLB][512 + h * 128 + dk] - p.in[I_HLB][h * 128 + dk]);
            const float sg = sigmoidf_(fz);
            qs[idx] = siluf_(q); fs[idx] = lb + (1.f - lb) * sg; ks[idx] = (1.f - lb) * (1.f - sg); vs[idx] = bf2f(PROJ[ro + 1024]); }
        LDSBAR();
#pragma unroll 2
        for (int t = 0; t < nb; ++t) { float o = 0.f; const float vt = vs[t * 128 + dv];
#pragma unroll
            for (int i4 = 0; i4 < 8; ++i4) { const f32x4 f4 = *(const f32x4*)(fs + t * 128 + dq * 32 + i4 * 4), k4 = *(const f32x4*)(ks + t * 128 + dq * 32 + i4 * 4), q4 = *(const f32x4*)(qs + t * 128 + dq * 32 + i4 * 4);
#pragma unroll
                for (int e = 0; e < 4; ++e) { const int i = i4 * 4 + e; S[i] = f4[e] * S[i] + k4[e] * vt; o += q4[e] * S[i]; } }
            op[(t * 4 + dq) * 128 + dv] = o; }
        LDSBAR();
        for (int t = wid; t < nb; t += 8) { const int row = base + t0 + t;
            const float o0 = op[(t * 4 + 0) * 128 + lane] + op[(t * 4 + 1) * 128 + lane] + op[(t * 4 + 2) * 128 + lane] + op[(t * 4 + 3) * 128 + lane];
            const float o1 = op[(t * 4 + 0) * 128 + lane + 64] + op[(t * 4 + 1) * 128 + lane + 64] + op[(t * 4 + 2) * 128 + lane + 64] + op[(t * 4 + 3) * 128 + lane + 64];
            const float ss = wave_sum(o0 * o0 + o1 * o1), r = rsqrtf(ss * (1.f / 128.f) + EPSN);
            const float g0 = bf2f(PROJ[(size_t)row * 3072 + 1536 + h * 128 + lane]), g1 = bf2f(PROJ[(size_t)row * 3072 + 1536 + h * 128 + lane + 64]);
            O[(size_t)row * 1024 + h * 128 + lane] = f2bf(o0 * r * gn0 * siluf_(g0)); O[(size_t)row * 1024 + h * 128 + lane + 64] = f2bf(o1 * r * gn1 * siluf_(g1)); }
    }
    float* so = s < 8 ? p.out + OO_HGP + (((size_t)j * 8 + s) * 4 + h) * 16384 : p.out + OO_HGS + (((size_t)j * 128 + (s - 8)) * 4 + h) * 16384;
#pragma unroll
    for (int i = 0; i < 32; ++i) so[(dq * 32 + i) * 128 + dv] = S[i];
}


__device__ __forceinline__ f32x4 mfma16(bf16x8 a, bf16x8 b, f32x4 c) { return __builtin_amdgcn_mfma_f32_16x16x32_bf16(a, b, c, 0, 0, 0); }
__device__ void hgrn_prep_unit(KParams& p, int j, int u, unsigned char* shm) {
    const int tid = tid_opaque(), dk = tid & 127, seg = tid >> 7, lane = tid & 63, wid = tid >> 6, fr = lane & 15, fq = lane >> 4;
    const int c = u & 31, h = (u >> 5) & 3, b = u >> 7;
    const bf16_t* PROJ = (const bf16_t*)(p.ws + WS_PROJ);
    unsigned char* hp = p.ws + WS_HP + (size_t)u * HP_UNIT;
    bf16_t* gqe = (bf16_t*)hp; bf16_t* gpp = gqe + 8192; bf16_t* gkdt = gpp + 8192; bf16_t* gvt = gkdt + 8192; float* gbr = (float*)(hp + 65536); float* gbt = gbr + 128;
    bf16_t* lqe = (bf16_t*)shm; bf16_t* lke = (bf16_t*)(shm + 17408); float* segs = (float*)(shm + 40960);
    float lbv = 0.f;
    if (j == 1) lbv = sigmoidf_(p.in[I_HLB][512 + h * 128 + dk] - p.in[I_HLB][h * 128 + dk]);
    const size_t r0 = (size_t)b * 2048 + c * 64;
    float qq[16], kk[16], bl[16]; float run = 0.f;
#pragma unroll
    for (int i = 0; i < 16; ++i) { const size_t ro = (r0 + seg * 16 + i) * 3072 + h * 128 + dk;
        const float q = bf2f(PROJ[ro]), fz = bf2f(PROJ[ro + 512]); const float sg = sigmoidf_(fz);
        const float f = lbv + (1.f - lbv) * sg; kk[i] = (1.f - lbv) * (1.f - sg); qq[i] = siluf_(q); run += __logf(f); bl[i] = run; }
    unsigned vw[8];
#pragma unroll
    for (int i = 0; i < 8; ++i) { const size_t ro = (r0 + seg * 16 + 2 * i) * 3072 + 1024 + h * 128 + dk; vw[i] = (unsigned)PROJ[ro] | ((unsigned)PROJ[ro + 3072] << 16); }
    __syncthreads();
    segs[seg * 128 + dk] = run;
    __syncthreads();
    const float s0 = segs[dk], s1 = segs[128 + dk], s2 = segs[256 + dk], s3 = segs[384 + dk];
    const float bref = s0 + s1, tot = bref + s2 + s3, off = seg == 0 ? 0.f : (seg == 1 ? s0 : (seg == 2 ? bref : bref + s2));
    unsigned kdw[8];
#pragma unroll
    for (int i = 0; i < 16; ++i) { const float bb = off + bl[i]; const int t = seg * 16 + i;
        const bf16_t qv = f2bf(qq[i] * __expf(bb - bref)); gqe[t * 128 + dk] = qv; lqe[t * 136 + dk] = qv; lke[t * 136 + dk] = f2bf(kk[i] * __expf(bref - bb));
        const unsigned kd = f2bf(kk[i] * __expf(tot - bb)); if (i & 1) kdw[i >> 1] |= kd << 16; else kdw[i >> 1] = kd; }
    u32x4 w0, w1; w0[0] = kdw[0]; w0[1] = kdw[1]; w0[2] = kdw[2]; w0[3] = kdw[3]; w1[0] = kdw[4]; w1[1] = kdw[5]; w1[2] = kdw[6]; w1[3] = kdw[7];
    *(u32x4*)(gkdt + dk * 64 + seg * 16) = w0; *(u32x4*)(gkdt + dk * 64 + seg * 16 + 8) = w1;
    w0[0] = vw[0]; w0[1] = vw[1]; w0[2] = vw[2]; w0[3] = vw[3]; w1[0] = vw[4]; w1[1] = vw[5]; w1[2] = vw[6]; w1[3] = vw[7];
    *(u32x4*)(gvt + dk * 64 + seg * 16) = w0; *(u32x4*)(gvt + dk * 64 + seg * 16 + 8) = w1;
    if (seg == 0) { gbr[dk] = bref; gbt[dk] = tot; }
    __syncthreads();
    {
        const int ti = wid >> 1, si0 = (wid & 1) * 2;
#pragma unroll
        for (int q = 0; q < 2; ++q) { const int si = si0 + q; f32x4 a = (f32x4){0.f, 0.f, 0.f, 0.f};
            if (si <= ti) {
#pragma unroll
                for (int k4 = 0; k4 < 4; ++k4) a = mfma16(*(const bf16x8*)(lqe + (ti * 16 + fr) * 136 + k4 * 32 + fq * 8), *(const bf16x8*)(lke + (si * 16 + fr) * 136 + k4 * 32 + fq * 8), a); }
#pragma unroll
            for (int jj = 0; jj < 4; ++jj) { const int t = ti * 16 + fq * 4 + jj, sx = si * 16 + fr; gpp[t * 64 + sx] = f2bf(sx <= t ? a[jj] : 0.f); } }
    }
}
__device__ void hgrn_prompt_unit(KParams& p, int j, int b, int h, unsigned char* shm) {
    const int tid = tid_opaque(), lane = tid & 63, wid = tid >> 6, fr = lane & 15, fq = lane >> 4;
    const bf16_t* PROJ = (const bf16_t*)(p.ws + WS_PROJ); bf16_t* O = (bf16_t*)(p.ws + WS_O);
    constexpr int QE = 0, KE = 17408, KDT = 34816, VT = 53248, PP = 71680, STS = 80896;
    bf16_t* qe = (bf16_t*)(shm + QE); bf16_t* ke = (bf16_t*)(shm + KE); bf16_t* kdt = (bf16_t*)(shm + KDT); bf16_t* vt = (bf16_t*)(shm + VT);
    bf16_t* pp = (bf16_t*)(shm + PP); bf16_t* sts = (bf16_t*)(shm + STS); float* ob = (float*)(shm + KDT);
    const unsigned char* hp0 = p.ws + WS_HP + (size_t)((b * 4 + h) * 32) * HP_UNIT;
    f32x4 Sacc[8];
#pragma unroll
    for (int i = 0; i < 8; ++i) Sacc[i] = (f32x4){0.f, 0.f, 0.f, 0.f};
    u32x4 rq[2], rp, rd[2], rv[2]; float brv[8], btv[8];
#define HG_FETCH(cc) do { const unsigned char* hp = hp0 + (size_t)(cc) * HP_UNIT; \
        _Pragma("unroll") for (int q = 0; q < 2; ++q) { const int ch = tid + q * 512; rq[q] = *(const u32x4*)(hp + ch * 16); rd[q] = *(const u32x4*)(hp + 32768 + ch * 16); rv[q] = *(const u32x4*)(hp + 49152 + ch * 16); } \
        rp = *(const u32x4*)(hp + 16384 + tid * 16); \
        _Pragma("unroll") for (int td = 0; td < 8; ++td) { brv[td] = ((const float*)(hp + 65536))[td * 16 + fr]; btv[td] = ((const float*)(hp + 65536))[128 + td * 16 + fr]; } } while (0)
    float gnv[16];
    { const float* gn = p.in[I_HGN] + j * 512 + h * 128 + (tid & 7) * 16;
#pragma unroll
      for (int q = 0; q < 16; ++q) gnv[q] = gn[q]; }
    HG_FETCH(0);
    for (int c = 0; c < 32; ++c) {
        const size_t r0 = (size_t)b * 2048 + c * 64;
        LDSBAR();
        float dec[8];
#pragma unroll
        for (int q = 0; q < 2; ++q) { const int ch = tid + q * 512;
            *(u32x4*)(qe + (ch >> 4) * 136 + (ch & 15) * 8) = rq[q];
            *(u32x4*)(kdt + (ch >> 3) * 72 + (ch & 7) * 8) = rd[q]; *(u32x4*)(vt + (ch >> 3) * 72 + (ch & 7) * 8) = rv[q]; }
        *(u32x4*)(pp + (tid >> 3) * 72 + (tid & 7) * 8) = rp;
#pragma unroll
        for (int td = 0; td < 8; ++td) { const float sc = __expf(brv[td]); dec[td] = __expf(btv[td]);
#pragma unroll
            for (int jj = 0; jj < 4; ++jj) sts[(wid * 16 + fq * 4 + jj) * 136 + td * 16 + fr] = f2bf(Sacc[td][jj] * sc); }
        if (c + 1 < 32) HG_FETCH(c + 1);
        const int et = tid >> 3, part = tid & 7; const size_t erow = r0 + et;
        const u32x4 g0 = *(const u32x4*)(PROJ + erow * 3072 + 1536 + h * 128 + part * 16), g1 = *(const u32x4*)(PROJ + erow * 3072 + 1536 + h * 128 + part * 16 + 8);
        LDSBAR();
        f32x4 oacc[4];
        {
            const int ti = wid & 3, dv0 = (wid >> 2) * 4;
#pragma unroll
            for (int d = 0; d < 4; ++d) oacc[d] = (f32x4){0.f, 0.f, 0.f, 0.f};
#pragma unroll
            for (int k4 = 0; k4 < 4; ++k4) { const bf16x8 a = *(const bf16x8*)(qe + (ti * 16 + fr) * 136 + k4 * 32 + fq * 8);
#pragma unroll
                for (int d = 0; d < 4; ++d) oacc[d] = mfma16(a, *(const bf16x8*)(sts + ((dv0 + d) * 16 + fr) * 136 + k4 * 32 + fq * 8), oacc[d]); }
#pragma unroll
            for (int k2 = 0; k2 < 2; ++k2) { const bf16x8 a = *(const bf16x8*)(pp + (ti * 16 + fr) * 72 + k2 * 32 + fq * 8);
#pragma unroll
                for (int d = 0; d < 4; ++d) oacc[d] = mfma16(a, *(const bf16x8*)(vt + ((dv0 + d) * 16 + fr) * 72 + k2 * 32 + fq * 8), oacc[d]); }
            const bf16x8 v0 = *(const bf16x8*)(vt + (wid * 16 + fr) * 72 + fq * 8), v1 = *(const bf16x8*)(vt + (wid * 16 + fr) * 72 + 32 + fq * 8);
#pragma unroll
            for (int td = 0; td < 8; ++td) { Sacc[td] = Sacc[td] * dec[td];
                Sacc[td] = mfma16(v0, *(const bf16x8*)(kdt + (td * 16 + fr) * 72 + fq * 8), Sacc[td]);
                Sacc[td] = mfma16(v1, *(const bf16x8*)(kdt + (td * 16 + fr) * 72 + 32 + fq * 8), Sacc[td]); }
        }
        LDSBAR();
        {
            const int ti = wid & 3, dv0 = (wid >> 2) * 4;
#pragma unroll
            for (int d = 0; d < 4; ++d)
#pragma unroll
                for (int jj = 0; jj < 4; ++jj) ob[(ti * 16 + fq * 4 + jj) * 132 + (dv0 + d) * 16 + fr] = oacc[d][jj];
        }
        LDSBAR();
        {
            float o[16]; float ss = 0.f;
#pragma unroll
            for (int q4 = 0; q4 < 4; ++q4) { const f32x4 v = *(const f32x4*)(ob + et * 132 + part * 16 + q4 * 4); o[q4 * 4] = v[0]; o[q4 * 4 + 1] = v[1]; o[q4 * 4 + 2] = v[2]; o[q4 * 4 + 3] = v[3];
                ss += v[0] * v[0] + v[1] * v[1] + v[2] * v[2] + v[3] * v[3]; }
            ss += __shfl_xor(ss, 1); ss += __shfl_xor(ss, 2); ss += __shfl_xor(ss, 4);
            const float r = rsqrtf(ss * (1.f / 128.f) + EPSN);
            u32x4 w0, w1;
#pragma unroll
            for (int q = 0; q < 4; ++q) {
                w0[q] = cvt_pk_bf16(o[2 * q] * r * gnv[2 * q] * siluf_(bflo(g0[q])), o[2 * q + 1] * r * gnv[2 * q + 1] * siluf_(bfhi(g0[q])));
                w1[q] = cvt_pk_bf16(o[8 + 2 * q] * r * gnv[8 + 2 * q] * siluf_(bflo(g1[q])), o[8 + 2 * q + 1] * r * gnv[8 + 2 * q + 1] * siluf_(bfhi(g1[q]))); }
            *(u32x4*)(O + erow * 1024 + h * 128 + part * 16) = w0; *(u32x4*)(O + erow * 1024 + h * 128 + part * 16 + 8) = w1;
        }
    }
#undef HG_FETCH
    float* so = p.out + OO_HGP + (((size_t)j * 8 + b) * 4 + h) * 16384;
#pragma unroll
    for (int td = 0; td < 8; ++td) *(f32x4*)(so + (size_t)(td * 16 + fr) * 128 + wid * 16 + fq * 4) = Sacc[td];
    LDSBAR();
}

__device__ void lru_scan_prompt(KParams& p, int j, int b, int cg16, unsigned char* shm) {
    const int tid = tid_opaque(), cl = tid & 15, ch = cg16 * 16 + cl, seg = tid >> 4;
    const float* LA = (const float*)(p.ws + WS_ON); const float* LBT = LA + (size_t)NTOK * 512;
    const bf16_t* PROJ = (const bf16_t*)(p.ws + WS_PROJ); bf16_t* O = (bf16_t*)(p.ws + WS_O);
    float* sA = (float*)shm; float* sH = sA + 512;
    const size_t r0 = (size_t)b * 2048 + seg * 64;
    float A = 1.f, H = 0.f;
    for (int t0 = 0; t0 < 64; t0 += 16) { float av[16], bv[16];
#pragma unroll
        for (int t = 0; t < 16; ++t) { av[t] = LA[(r0 + t0 + t) * 512 + ch]; bv[t] = LBT[(r0 + t0 + t) * 512 + ch]; }
#pragma unroll
        for (int t = 0; t < 16; ++t) { H = av[t] * H + bv[t]; A *= av[t]; } }
    __syncthreads();
    sA[tid] = A; sH[tid] = H;
    __syncthreads();
    float hc = 0.f;
    for (int s2 = 0; s2 < seg; ++s2) hc = sA[s2 * 16 + cl] * hc + sH[s2 * 16 + cl];
    for (int t0 = 0; t0 < 64; t0 += 16) { float av[16], bv[16], yv[16];
#pragma unroll
        for (int t = 0; t < 16; ++t) { av[t] = LA[(r0 + t0 + t) * 512 + ch]; bv[t] = LBT[(r0 + t0 + t) * 512 + ch]; yv[t] = bf2f(PROJ[(r0 + t0 + t) * 3072 + 2048 + ch]); }
#pragma unroll
        for (int t = 0; t < 16; ++t) { hc = av[t] * hc + bv[t]; O[(r0 + t0 + t) * 1024 + 512 + ch] = f2bf(geluf_(yv[t]) * hc); } }
    if (seg == 31) p.out[OO_LHP + ((size_t)j * 8 + b) * 512 + ch] = hc;
}
__device__ void lru_scan_sample(KParams& p, int j, int b) {
    const int ch = tid_opaque();
    const float* LA = (const float*)(p.ws + WS_ON); const float* LBT = LA + (size_t)NTOK * 512;
    const bf16_t* PROJ = (const bf16_t*)(p.ws + WS_PROJ); bf16_t* O = (bf16_t*)(p.ws + WS_O);
    float hc = p.in[I_SLH][((size_t)j * 128 + b) * 512 + ch];
    const size_t r0 = NPR + (size_t)b * 8;
#pragma unroll
    for (int t = 0; t < 8; ++t) { const float a = LA[(r0 + t) * 512 + ch], bt = LBT[(r0 + t) * 512 + ch]; hc = a * hc + bt;
        const float yb = bf2f(PROJ[(r0 + t) * 3072 + 2048 + ch]);
        O[(r0 + t) * 1024 + 512 + ch] = f2bf(geluf_(yb) * hc); }
    p.out[OO_LHS + ((size_t)j * 128 + b) * 512 + ch] = hc;
}
__device__ void phase_even_scan(KParams& p, int j, unsigned char* shm) {
    const int bid = bid_opaque(), G = gridDim.x;
    for (int w = bid - 32; w < 896; w += G - 32) {
        if (w < 512) { const int v = w + 32; hgrn_unit(p, j, v >> 2, v & 3, shm); }
        else if (w < 768) lru_scan_prompt(p, j, (w - 512) >> 5, (w - 512) & 31, shm);
        else lru_scan_sample(p, j, w - 768);
    }
}

__device__ void phase_conv_ssm(KParams& p, int j) {
    const bf16_t* PROJ = (const bf16_t*)(p.ws + WS_PROJ); bf16_t* XBC = (bf16_t*)(p.ws + WS_U);
    const float* cw = p.in[I_SCW] + (size_t)j * 4 * 3072; const float* cb = p.in[I_SCB] + (size_t)j * 3072;
    for (int idx = bid_opaque() * 512 + tid_opaque(); idx < 512 * 384; idx += gridDim.x * 512) {
        const int rb = idx / 384, c8 = (idx % 384) * 8, r0 = rb * 32, t0 = r0 & 2047, b = r0 >> 11;
        float w[4][8], bias[8], h[3][8];
#pragma unroll
        for (int k = 0; k < 4; ++k) { const f32x4 a = *(const f32x4*)(cw + k * 3072 + c8), c = *(const f32x4*)(cw + k * 3072 + c8 + 4);
            w[k][0] = a[0]; w[k][1] = a[1]; w[k][2] = a[2]; w[k][3] = a[3]; w[k][4] = c[0]; w[k][5] = c[1]; w[k][6] = c[2]; w[k][7] = c[3]; }
        { const f32x4 a = *(const f32x4*)(cb + c8), c = *(const f32x4*)(cb + c8 + 4); bias[0] = a[0]; bias[1] = a[1]; bias[2] = a[2]; bias[3] = a[3]; bias[4] = c[0]; bias[5] = c[1]; bias[6] = c[2]; bias[7] = c[3]; }
#pragma unroll
        for (int k = 0; k < 3; ++k) { u32x4 hw = (u32x4){0u, 0u, 0u, 0u}; if (t0 != 0) hw = *(const u32x4*)(PROJ + (size_t)(r0 - 3 + k) * 5376 + 2048 + c8);
#pragma unroll
            for (int q = 0; q < 4; ++q) { h[k][2 * q] = bflo(hw[q]); h[k][2 * q + 1] = bfhi(hw[q]); } }
        for (int rr = 0; rr < 32; rr += 8) { u32x4 in[8];
#pragma unroll
            for (int e = 0; e < 8; ++e) in[e] = *(const u32x4*)(PROJ + (size_t)(r0 + rr + e) * 5376 + 2048 + c8);
#pragma unroll
            for (int e = 0; e < 8; ++e) { float cur[8]; u32x4 ow;
#pragma unroll
                for (int q = 0; q < 4; ++q) { cur[2 * q] = bflo(in[e][q]); cur[2 * q + 1] = bfhi(in[e][q]); }
#pragma unroll
                for (int q = 0; q < 4; ++q) { const float o0 = bias[2 * q] + w[0][2 * q] * h[0][2 * q] + w[1][2 * q] * h[1][2 * q] + w[2][2 * q] * h[2][2 * q] + w[3][2 * q] * cur[2 * q];
                    const float o1 = bias[2 * q + 1] + w[0][2 * q + 1] * h[0][2 * q + 1] + w[1][2 * q + 1] * h[1][2 * q + 1] + w[2][2 * q + 1] * h[2][2 * q + 1] + w[3][2 * q + 1] * cur[2 * q + 1];
                    ow[q] = cvt_pk_bf16(siluf_(o0), siluf_(o1)); }
                *(u32x4*)(XBC + (size_t)(r0 + rr + e) * 3072 + c8) = ow;
#pragma unroll
                for (int q = 0; q < 8; ++q) { h[0][q] = h[1][q]; h[1][q] = h[2][q]; h[2][q] = cur[q]; } } }
        if (t0 + 32 == 2048) { float* dst = p.out + OO_SCP + (((size_t)j * 8 + b) * 3) * 3072 + c8;
#pragma unroll
            for (int k = 0; k < 3; ++k)
#pragma unroll
                for (int q = 0; q < 8; ++q) dst[(size_t)k * 3072 + q] = h[k][q]; }
    }
    for (int idx = bid_opaque() * 512 + tid_opaque(); idx < 1024 * 384; idx += gridDim.x * 512) {
        const int row = NPR + idx / 384, c8 = (idx % 384) * 8;
        int t, L, b; const bool pr = row < NPR;
        if (pr) { t = row & 2047; L = 2048; b = row >> 11; } else { t = (row - NPR) & 7; L = 8; b = (row - NPR) >> 3; }
        float o[8], last[8];
#pragma unroll
        for (int q = 0; q < 8; ++q) o[q] = cb[c8 + q];
#pragma unroll
        for (int k = 0; k < 4; ++k) { const int m = t + k; float v[8];
            if (m >= 3) { const u32x4 w = *(const u32x4*)(PROJ + (size_t)(row + k - 3) * 5376 + 2048 + c8);
#pragma unroll
                for (int q = 0; q < 4; ++q) { v[2 * q] = bflo(w[q]); v[2 * q + 1] = bfhi(w[q]); } }
            else if (!pr) { const float* sp = p.in[I_SSC] + (((size_t)j * 128 + b) * 3 + m) * 3072 + c8;
#pragma unroll
                for (int q = 0; q < 8; ++q) v[q] = sp[q]; }
            else {
#pragma unroll
                for (int q = 0; q < 8; ++q) v[q] = 0.f; }
#pragma unroll
            for (int q = 0; q < 8; ++q) { o[q] += cw[k * 3072 + c8 + q] * v[q]; if (k == 3) last[q] = v[q]; } }
        u32x4 w;
#pragma unroll
        for (int q = 0; q < 4; ++q) w[q] = cvt_pk_bf16(siluf_(o[2 * q]), siluf_(o[2 * q + 1]));
        *(u32x4*)(XBC + (size_t)row * 3072 + c8) = w;
        if (t >= L - 3) { const int r = t - (L - 3);
            float* dst = pr ? p.out + OO_SCP + (((size_t)j * 8 + b) * 3 + r) * 3072 + c8 : p.out + OO_SCS + (((size_t)j * 128 + b) * 3 + r) * 3072 + c8;
#pragma unroll
            for (int q = 0; q < 8; ++q) dst[q] = last[q]; }
    }
    float* DT = (float*)(p.ws + WS_DT); float* DA = DT + (size_t)NTOK * 32;
    for (int idx = bid_opaque() * 512 + tid_opaque(); idx < NTOK * 32; idx += gridDim.x * 512) {
        const int row = idx >> 5, h = idx & 31;
        const float dt = softplusf_(bf2f(PROJ[(size_t)row * 5376 + 5120 + h]) + p.in[I_SDTB][j * 32 + h]);
        DT[idx] = dt; DA[idx] = __expf(-dt * __expf(p.in[I_SALOG][j * 32 + h]));
    }
}

__device__ void ssd_unit(KParams& p, int j, int s, int h, unsigned char* shm) {
    const int tid = tid_opaque(), pp = tid & 63, nq = tid >> 6, g = h >> 3;
    const bf16_t* PROJ = (const bf16_t*)(p.ws + WS_PROJ); const bf16_t* XBC = (const bf16_t*)(p.ws + WS_U); bf16_t* O = (bf16_t*)(p.ws + WS_O);
    const float* DT = (const float*)(p.ws + WS_DT); const float* DA = DT + (size_t)NTOK * 32;
    u64* GSS = (u64*)(p.ws + WS_RSS) + 8 * (size_t)NTOK + (size_t)j * NTOK * 4;
    float* Bs = (float*)shm; float* Cs = Bs + 16 * 128; float* xs = Cs + 16 * 128; float* dts = xs + 16 * 64; float* das = dts + 16; float* yp = das + 16;
    const int base = seq_base(s), L = seq_len(s), nb = L < 16 ? L : 16;
    const float Dh = p.in[I_SD][j * 32 + h];
    float S[16];
    if (s >= 8) { const float* s0 = p.in[I_SSM] + ((((size_t)j * 128 + (s - 8)) * 32 + h) * 64 + pp) * 128 + nq * 16;
#pragma unroll
        for (int i4 = 0; i4 < 4; ++i4) { const f32x4 v = *(const f32x4*)(s0 + i4 * 4); S[i4 * 4] = v[0]; S[i4 * 4 + 1] = v[1]; S[i4 * 4 + 2] = v[2]; S[i4 * 4 + 3] = v[3]; } }
    else {
#pragma unroll
        for (int i = 0; i < 16; ++i) S[i] = 0.f; }
    for (int t0 = 0; t0 < L; t0 += nb) {
        __syncthreads();
        for (int idx = tid; idx < nb * 128; idx += 512) { const int t = idx >> 7, n = idx & 127; const size_t ro = (size_t)(base + t0 + t) * 3072;
            Bs[idx] = bf2f(XBC[ro + 2048 + g * 128 + n]); Cs[idx] = bf2f(XBC[ro + 2560 + g * 128 + n]); }
        for (int idx = tid; idx < nb * 64; idx += 512) { const int t = idx >> 6, q = idx & 63; xs[idx] = bf2f(XBC[(size_t)(base + t0 + t) * 3072 + h * 64 + q]); }
        if (tid < nb) { dts[tid] = DT[(size_t)(base + t0 + tid) * 32 + h]; das[tid] = DA[(size_t)(base + t0 + tid) * 32 + h]; }
        __syncthreads();
#pragma unroll 2
        for (int t = 0; t < nb; ++t) { { const float xdt = xs[t * 64 + pp] * dts[t], da = das[t]; float y = 0.f;
#pragma unroll
                for (int i4 = 0; i4 < 4; ++i4) { const f32x4 b4 = *(const f32x4*)(Bs + t * 128 + nq * 16 + i4 * 4), c4 = *(const f32x4*)(Cs + t * 128 + nq * 16 + i4 * 4);
#pragma unroll
                    for (int e = 0; e < 4; ++e) { const int i = i4 * 4 + e; S[i] = da * S[i] + xdt * b4[e]; y += c4[e] * S[i]; } }
                yp[(t * 8 + nq) * 64 + pp] = y; } }
        __syncthreads();
        for (int t = nq; t < nb; t += 8) { const int row = base + t0 + t; float y = Dh * xs[t * 64 + pp];
#pragma unroll
            for (int q = 0; q < 8; ++q) y += yp[(t * 8 + q) * 64 + pp];
            const float z = bf2f(PROJ[(size_t)row * 5376 + h * 64 + pp]);
            y *= siluf_(z);
            O[(size_t)row * 2048 + h * 64 + pp] = f2bf(y);
            const float ss = wave_sum(y * y);
            if (pp == 0) atomicAdd(GSS + (size_t)g * NTOK + row, (u64)(ss * FXS)); }
    }
    float* so = s < 8 ? p.out + OO_SSP + ((((size_t)j * 8 + s) * 32 + h) * 64 + pp) * 128 + nq * 16 : p.out + OO_SSS + ((((size_t)j * 128 + (s - 8)) * 32 + h) * 64 + pp) * 128 + nq * 16;
#pragma unroll
    for (int i4 = 0; i4 < 4; ++i4) { f32x4 v; v[0] = S[i4 * 4]; v[1] = S[i4 * 4 + 1]; v[2] = S[i4 * 4 + 2]; v[3] = S[i4 * 4 + 3]; *(f32x4*)(so + i4 * 4) = v; }
}

__device__ void ssd_prompt_unit(KParams& p, int j, int b, int h, unsigned char* shm) {
    const int tid = tid_opaque(), lane = tid & 63, wid = tid >> 6, fr = lane & 15, fq = lane >> 4, g = h >> 3;
    const bf16_t* PROJ = (const bf16_t*)(p.ws + WS_PROJ); const bf16_t* XBC = (const bf16_t*)(p.ws + WS_U); bf16_t* O = (bf16_t*)(p.ws + WS_O);
    const float* DT = (const float*)(p.ws + WS_DT);
    u64* GSS = (u64*)(p.ws + WS_RSS) + 8 * (size_t)NTOK + (size_t)j * NTOK * 4;
    constexpr int CM = 0, BM = 17408, BMT = 34816, XT = 53248, XWT = 62464, PP = 71680, SB = 80896, CUM = 98304, DTS = 98560, GP = 98816;
    bf16_t* cm = (bf16_t*)(shm + CM); bf16_t* bm = (bf16_t*)(shm + BM); bf16_t* bmt = (bf16_t*)(shm + BMT); bf16_t* xt = (bf16_t*)(shm + XT); bf16_t* xwt = (bf16_t*)(shm + XWT);
    bf16_t* pp = (bf16_t*)(shm + PP); bf16_t* sb = (bf16_t*)(shm + SB); float* cum = (float*)(shm + CUM); float* dts = (float*)(shm + DTS); float* gpart = (float*)(shm + GP);
    const float Ah = -__expf(p.in[I_SALOG][j * 32 + h]), Dh = p.in[I_SD][j * 32 + h];
    const int pt = wid >> 1, nt0 = (wid & 1) * 4;
    f32x4 Sacc[4];
#pragma unroll
    for (int q = 0; q < 4; ++q) Sacc[q] = (f32x4){0.f, 0.f, 0.f, 0.f};
    u32x4 cw[2], bw[2], xw; float dtv = 0.f; bf16_t zv[8];
    const int xrow = tid >> 3, xc8 = tid & 7;
#define SSD_FETCH(cc) do { const size_t rn = (size_t)b * 2048 + (cc) * 64; \
        _Pragma("unroll") for (int q = 0; q < 2; ++q) { const int ch = tid + q * 512, row = ch >> 4, c16 = ch & 15; const size_t ro = (rn + row) * 3072 + g * 128 + c16 * 8; \
            bw[q] = *(const u32x4*)(XBC + ro + 2048); cw[q] = *(const u32x4*)(XBC + ro + 2560); } \
        xw = *(const u32x4*)(XBC + (rn + xrow) * 3072 + h * 64 + xc8 * 8); \
        if (wid == 0) dtv = DT[(rn + lane) * 32 + h]; \
        _Pragma("unroll") for (int q = 0; q < 2; ++q) _Pragma("unroll") for (int jj = 0; jj < 4; ++jj) \
            zv[q * 4 + jj] = PROJ[(rn + (wid >> 1) * 16 + fq * 4 + jj) * 5376 + h * 64 + ((wid & 1) * 2 + q) * 16 + fr]; } while (0)
    SSD_FETCH(0);
    for (int c = 0; c < 32; ++c) {
        const size_t r0 = (size_t)b * 2048 + c * 64;
        if (c > 0 && wid == 0) atomicAdd(GSS + (size_t)g * NTOK + (r0 - 64) + lane, (u64)((gpart[lane] + gpart[64 + lane]) * FXS));
        if (wid == 0) { const float dt = dtv; float la = dt * Ah;
#pragma unroll
            for (int o = 1; o < 64; o <<= 1) { const float t = __shfl_up(la, o); if (lane >= o) la += t; }
            cum[lane] = la; dts[lane] = dt; }
        bf16_t zc[8];
#pragma unroll
        for (int q = 0; q < 8; ++q) zc[q] = zv[q];
        LDSBAR();
        {
#pragma unroll
            for (int q = 0; q < 2; ++q) { const int ch = tid + q * 512, row = ch >> 4, c16 = ch & 15;
                *(u32x4*)(cm + row * 136 + c16 * 8) = cw[q]; *(u32x4*)(bm + row * 136 + c16 * 8) = bw[q];
#pragma unroll
                for (int e = 0; e < 4; ++e) { const int rs = row ^ ((c16 & 7) << 3); bmt[(c16 * 8 + 2 * e) * 72 + rs] = (bf16_t)(bw[q][e] & 0xffffu); bmt[(c16 * 8 + 2 * e + 1) * 72 + rs] = (bf16_t)(bw[q][e] >> 16); } }
            const float wsc = __expf(cum[63] - cum[xrow]) * dts[xrow];
#pragma unroll
            for (int e = 0; e < 4; ++e) { const bf16_t lo = (bf16_t)(xw[e] & 0xffffu), hi = (bf16_t)(xw[e] >> 16);
                const int xs_ = xrow ^ (xc8 << 3);
                xt[(xc8 * 8 + 2 * e) * 72 + xs_] = lo; xt[(xc8 * 8 + 2 * e + 1) * 72 + xs_] = hi;
                xwt[(xc8 * 8 + 2 * e) * 72 + xs_] = f2bf(bf2f(lo) * wsc); xwt[(xc8 * 8 + 2 * e + 1) * 72 + xs_] = f2bf(bf2f(hi) * wsc); }
#pragma unroll
            for (int q = 0; q < 4; ++q)
#pragma unroll
                for (int jj = 0; jj < 4; ++jj) sb[(pt * 16 + fq * 4 + jj) * 136 + (nt0 + q) * 16 + fr] = f2bf(Sacc[q][jj]);
        }
        if (c + 1 < 32) SSD_FETCH(c + 1);
        LDSBAR();
        {
            const int ti = wid >> 1, si0 = (wid & 1) * 2;
#pragma unroll
            for (int q = 0; q < 2; ++q) { const int si = si0 + q; f32x4 a = (f32x4){0.f, 0.f, 0.f, 0.f};
                if (si <= ti) {
#pragma unroll
                    for (int k4 = 0; k4 < 4; ++k4) a = mfma16(*(const bf16x8*)(cm + (ti * 16 + fr) * 136 + k4 * 32 + fq * 8), *(const bf16x8*)(bm + (si * 16 + fr) * 136 + k4 * 32 + fq * 8), a); }
                const int s2 = si * 16 + fr; const float cs = cum[s2], ds = dts[s2];
#pragma unroll
                for (int jj = 0; jj < 4; ++jj) { const int t = ti * 16 + fq * 4 + jj; const float v = a[jj] * __expf(cum[t] - cs) * ds; pp[t * 72 + s2] = f2bf(s2 <= t ? v : 0.f); } }
        }
        LDSBAR();
        {
            const int ti = wid >> 1, pi0 = (wid & 1) * 2;
            f32x4 oa[2];
#pragma unroll
            for (int q = 0; q < 2; ++q) oa[q] = (f32x4){0.f, 0.f, 0.f, 0.f};
#pragma unroll
            for (int k4 = 0; k4 < 4; ++k4) { const bf16x8 a = *(const bf16x8*)(cm + (ti * 16 + fr) * 136 + k4 * 32 + fq * 8);
#pragma unroll
                for (int q = 0; q < 2; ++q) oa[q] = mfma16(a, *(const bf16x8*)(sb + ((pi0 + q) * 16 + fr) * 136 + k4 * 32 + fq * 8), oa[q]); }
            float ec[4];
#pragma unroll
            for (int jj = 0; jj < 4; ++jj) ec[jj] = __expf(cum[ti * 16 + fq * 4 + jj]);
#pragma unroll
            for (int q = 0; q < 2; ++q)
#pragma unroll
                for (int jj = 0; jj < 4; ++jj) oa[q][jj] *= ec[jj];
#pragma unroll
            for (int k2 = 0; k2 < 2; ++k2) { const bf16x8 a = *(const bf16x8*)(pp + (ti * 16 + fr) * 72 + k2 * 32 + fq * 8);
#pragma unroll
                for (int q = 0; q < 2; ++q) oa[q] = mfma16(a, *(const bf16x8*)(xt + ((pi0 + q) * 16 + fr) * 72 + ((k2 * 32 + fq * 8) ^ (((((pi0 + q) * 16 + fr) >> 3) & 7) << 3))), oa[q]); }
            float ss[4] = {0.f, 0.f, 0.f, 0.f};
#pragma unroll
            for (int q = 0; q < 2; ++q)
#pragma unroll
                for (int jj = 0; jj < 4; ++jj) { const int t = ti * 16 + fq * 4 + jj, pc = (pi0 + q) * 16 + fr; const size_t row = r0 + t;
                    float y = oa[q][jj] + Dh * bf2f(xt[pc * 72 + (t ^ (((pc >> 3) & 7) << 3))]);
                    y *= siluf_(bf2f(zc[q * 4 + jj]));
                    O[row * 2048 + h * 64 + pc] = f2bf(y); ss[jj] += y * y; }
#pragma unroll
            for (int jj = 0; jj < 4; ++jj) { float v = ss[jj]; v += __shfl_xor(v, 1); v += __shfl_xor(v, 2); v += __shfl_xor(v, 4); v += __shfl_xor(v, 8);
                if (fr == 0) gpart[(wid & 1) * 64 + ti * 16 + fq * 4 + jj] = v; }
            const float dec = __expf(cum[63]);
            const int xsw = (((pt * 16 + fr) >> 3) & 7) << 3;
            const bf16x8 a0 = *(const bf16x8*)(xwt + (pt * 16 + fr) * 72 + ((fq * 8) ^ xsw)), a1 = *(const bf16x8*)(xwt + (pt * 16 + fr) * 72 + ((32 + fq * 8) ^ xsw));
#pragma unroll
            for (int q = 0; q < 4; ++q) { Sacc[q] = Sacc[q] * dec;
                const int bsw = (((((nt0 + q) * 16 + fr) >> 3) & 7) << 3);
                Sacc[q] = mfma16(a0, *(const bf16x8*)(bmt + ((nt0 + q) * 16 + fr) * 72 + ((fq * 8) ^ bsw)), Sacc[q]);
                Sacc[q] = mfma16(a1, *(const bf16x8*)(bmt + ((nt0 + q) * 16 + fr) * 72 + ((32 + fq * 8) ^ bsw)), Sacc[q]); }
        }
        LDSBAR();
    }
#undef SSD_FETCH
    if (wid == 0) atomicAdd(GSS + (size_t)g * NTOK + ((size_t)b * 2048 + 31 * 64) + lane, (u64)((gpart[lane] + gpart[64 + lane]) * FXS));
    float* so = p.out + OO_SSP + ((((size_t)j * 8 + b) * 32 + h) * 64) * 128;
#pragma unroll
    for (int q = 0; q < 4; ++q)
#pragma unroll
        for (int jj = 0; jj < 4; ++jj) so[(size_t)(pt * 16 + fq * 4 + jj) * 128 + (nt0 + q) * 16 + fr] = Sacc[q][jj];
}


__device__ void ssd_sample_loop(KParams& p, int j, int u0, int ustep, unsigned char* shm) {
    const int tid = tid_opaque(), pp = tid & 63, nq = tid >> 6;
    const bf16_t* PROJ = (const bf16_t*)(p.ws + WS_PROJ); const bf16_t* XBC = (const bf16_t*)(p.ws + WS_U); bf16_t* O = (bf16_t*)(p.ws + WS_O);
    const float* DT = (const float*)(p.ws + WS_DT); const float* DA = DT + (size_t)NTOK * 32;
    u64* GSS = (u64*)(p.ws + WS_RSS) + 8 * (size_t)NTOK + (size_t)j * NTOK * 4;
    float* Bs = (float*)shm; float* Cs = Bs + 8 * 128; float* xs = Cs + 8 * 128; float* dts = xs + 8 * 64; float* das = dts + 8; float* yp = das + 8;
    float* stg = (float*)(shm + 32768);
    f32x4 s0[4]; bf16_t bv[2], cv[2], xv, zv; float dtv = 0.f, dav = 0.f;
#define SS_FETCH(uu) do { const int b_ = (uu) >> 5, h_ = (uu) & 31, g_ = h_ >> 3; const size_t base_ = NPR + (size_t)b_ * 8; \
        const float* sp = p.in[I_SSM] + (((size_t)j * 128 + b_) * 32 + h_) * 8192 + tid * 4; \
        _Pragma("unroll") for (int i4 = 0; i4 < 4; ++i4) s0[i4] = *(const f32x4*)(sp + i4 * 2048); \
        _Pragma("unroll") for (int q = 0; q < 2; ++q) { const int idx = tid + q * 512, t = idx >> 7, n = idx & 127; const size_t ro = (base_ + t) * 3072; bv[q] = XBC[ro + 2048 + g_ * 128 + n]; cv[q] = XBC[ro + 2560 + g_ * 128 + n]; } \
        xv = XBC[(base_ + nq) * 3072 + h_ * 64 + pp]; zv = PROJ[(base_ + nq) * 5376 + h_ * 64 + pp]; \
        if (tid < 8) { dtv = DT[(base_ + tid) * 32 + h_]; dav = DA[(base_ + tid) * 32 + h_]; } } while (0)
    if (u0 < 4096) SS_FETCH(u0);
    for (int u = u0; u < 4096; u += ustep) {
        const int b = u >> 5, h = u & 31, g = h >> 3; const size_t base = NPR + (size_t)b * 8;
        const float Dh = p.in[I_SD][j * 32 + h];
        LDSBAR();
#pragma unroll
        for (int i4 = 0; i4 < 4; ++i4) { const int ci = tid + i4 * 512; *(f32x4*)(stg + (ci >> 5) * 132 + (ci & 31) * 4) = s0[i4]; }
#pragma unroll
        for (int q = 0; q < 2; ++q) { Bs[tid + q * 512] = bf2f(bv[q]); Cs[tid + q * 512] = bf2f(cv[q]); }
        xs[tid] = bf2f(xv); const float zc = bf2f(zv);
        if (tid < 8) { dts[tid] = dtv; das[tid] = dav; }
        LDSBAR();
        float S[16];
#pragma unroll
        for (int i4 = 0; i4 < 4; ++i4) { const f32x4 v = *(const f32x4*)(stg + pp * 132 + nq * 16 + i4 * 4); S[i4 * 4] = v[0]; S[i4 * 4 + 1] = v[1]; S[i4 * 4 + 2] = v[2]; S[i4 * 4 + 3] = v[3]; }
        if (u + ustep < 4096) SS_FETCH(u + ustep);
#pragma unroll 2
        for (int t = 0; t < 8; ++t) { const float xdt = xs[t * 64 + pp] * dts[t], da = das[t]; float y = 0.f;
#pragma unroll
            for (int i4 = 0; i4 < 4; ++i4) { const f32x4 b4 = *(const f32x4*)(Bs + t * 128 + nq * 16 + i4 * 4), c4 = *(const f32x4*)(Cs + t * 128 + nq * 16 + i4 * 4);
#pragma unroll
                for (int e = 0; e < 4; ++e) { const int i = i4 * 4 + e; S[i] = da * S[i] + xdt * b4[e]; y += c4[e] * S[i]; } }
            yp[(t * 8 + nq) * 64 + pp] = y; }
        LDSBAR();
        { const int t = nq; const size_t row = base + t; float y = Dh * xs[t * 64 + pp];
#pragma unroll
            for (int q = 0; q < 8; ++q) y += yp[(t * 8 + q) * 64 + pp];
            y *= siluf_(zc);
            O[row * 2048 + h * 64 + pp] = f2bf(y);
            const float ss = wave_sum(y * y);
            if (pp == 0) atomicAdd(GSS + (size_t)g * NTOK + row, (u64)(ss * FXS)); }
#pragma unroll
        for (int i4 = 0; i4 < 4; ++i4) { f32x4 v; v[0] = S[i4 * 4]; v[1] = S[i4 * 4 + 1]; v[2] = S[i4 * 4 + 2]; v[3] = S[i4 * 4 + 3]; *(f32x4*)(stg + pp * 132 + nq * 16 + i4 * 4) = v; }
        LDSBAR();
        float* so = p.out + OO_SSS + (((size_t)j * 128 + b) * 32 + h) * 8192 + tid * 4;
#pragma unroll
        for (int i4 = 0; i4 < 4; ++i4) { const int ci = tid + i4 * 512; *(f32x4*)(so + i4 * 2048) = *(const f32x4*)(stg + (ci >> 5) * 132 + (ci & 31) * 4); }
    }
#undef SS_FETCH
}

__device__ void phase_ssd(KParams& p, int j, unsigned char* shm) {
    const int bid = bid_opaque(), G = gridDim.x;
    for (int u = bid; u < 256; u += G) ssd_prompt_unit(p, j, u >> 5, u & 31, shm);
    ssd_sample_loop(p, j, bid, G, shm);
}
__device__ void phase_gnorm(KParams& p, int j) {
    const bf16_t* O = (const bf16_t*)(p.ws + WS_O); bf16_t* ON = (bf16_t*)(p.ws + WS_ON);
    const u64* GSS = (const u64*)(p.ws + WS_RSS) + 8 * (size_t)NTOK + (size_t)j * NTOK * 4;
    const float* gn = p.in[I_SGN] + (size_t)j * 2048;
    for (int idx = bid_opaque() * 512 + tid_opaque(); idx < NTOK * 256; idx += gridDim.x * 512) {
        const int row = idx >> 8, c8 = (idx & 255) * 8;
        const float r = rsqrtf((float)GSS[(size_t)(c8 >> 9) * NTOK + row] * (FXI / 512.f) + EPSN);
        const u32x4 w = *(const u32x4*)(O + (size_t)row * 2048 + c8); u32x4 o;
#pragma unroll
        for (int q = 0; q < 4; ++q) o[q] = cvt_pk_bf16(bflo(w[q]) * r * gn[c8 + 2 * q], bfhi(w[q]) * r * gn[c8 + 2 * q + 1]);
        *(u32x4*)(ON + (size_t)row * 2048 + c8) = o;
    }
}

__device__ void phase_final(KParams& p) {
    const bf16_t* XH = (const bf16_t*)(p.ws + WS_XN); const u64* RSN = (const u64*)(p.ws + WS_RSS) + RSSN_OFF + 4 * (size_t)NTOK;
    const float* gm = p.in[I_GFIN];
    const int stride = gridDim.x * 512;
    for (int idx0 = bid_opaque() * 512 + tid_opaque(); idx0 < NTOK * 128; idx0 += 2 * stride) { u32x4 xw[2]; float rr[2];
#pragma unroll
        for (int k = 0; k < 2; ++k) { const int idx = idx0 + k * stride; xw[k] = (u32x4){0u, 0u, 0u, 0u}; rr[k] = 0.f;
            if (idx < NTOK * 128) { const int row = idx >> 7, c8 = (idx & 127) * 8; xw[k] = *(const u32x4*)(XH + (size_t)row * 1024 + c8); rr[k] = (float)RSN[row]; } }
#pragma unroll
        for (int k = 0; k < 2; ++k) { const int idx = idx0 + k * stride;
            if (idx < NTOK * 128) { const int row = idx >> 7, c8 = (idx & 127) * 8; const float r = rsqrtf(rr[k] * (FXI / 1024.f) + EPSN);
                const f32x4 g0 = *(const f32x4*)(gm + c8), g1 = *(const f32x4*)(gm + c8 + 4); f32x4 y0, y1;
                y0[0] = bflo(xw[k][0]) * r * g0[0]; y0[1] = bfhi(xw[k][0]) * r * g0[1]; y0[2] = bflo(xw[k][1]) * r * g0[2]; y0[3] = bfhi(xw[k][1]) * r * g0[3];
                y1[0] = bflo(xw[k][2]) * r * g1[0]; y1[1] = bfhi(xw[k][2]) * r * g1[1]; y1[2] = bflo(xw[k][3]) * r * g1[2]; y1[3] = bfhi(xw[k][3]) * r * g1[3];
                *(f32x4*)(p.out + OO_Y + (size_t)row * 1024 + c8) = y0; *(f32x4*)(p.out + OO_Y + (size_t)row * 1024 + c8 + 4) = y1; } }
    }
}

__global__ void __launch_bounds__(512, 2) mega(Params p_) {
    extern __shared__ __attribute__((aligned(16))) unsigned char shm[];
    cg::grid_group grid = cg::this_grid();
    LAS unsigned char* lds = (LAS unsigned char*)shm;
    const int G = gridDim.x;
    unsigned* bar = (unsigned*)(p_.ws + WS_BAR);
    volatile LAS unsigned* st = (volatile LAS unsigned*)(lds + 131072);
    if (threadIdx.x == 0) { st[0] = 0u; st[1] = 0u; st[2] = 0u; st[3] = 0u; }
    if (blockIdx.x == 0) for (int i = threadIdx.x; i < 2 * XCD_BAR_WORDS; i += 512) bar[i] = 0u;
    __syncthreads();
    XcdBarrier xb; xb.bar = bar; xb.x = 0u; xb.st = st; xb.expect = 0u;
    XcdBarrier xb2; xb2.bar = bar + XCD_BAR_WORDS; xb2.x = 0u; xb2.st = st + 2; xb2.expect = 0u;
    const int ph_lo = p_.ph_lo, ph_hi = p_.ph_hi;
    for (int ph = ph_lo; ph < ph_hi; ++ph) {
        const int bid = bid_opaque();
        LAS unsigned char* lds_l = lds; asm volatile("" : "+s"(lds_l));
        unsigned char* shm_l = (unsigned char*)lds_l;
        KParams* kp = (KParams*)__builtin_amdgcn_kernarg_segment_ptr();
        asm volatile("" : "+s"(kp));
        KParams& p = *kp;
        unsigned char* ws = p.ws;
        bf16_t* W = (bf16_t*)(ws + WS_W);
        bf16_t* XH = (bf16_t*)(ws + WS_XN);
        bf16_t* EB = (bf16_t*)(ws + WS_EB); bf16_t* PB = (bf16_t*)(ws + WS_PB);
        bf16_t* PROJ = (bf16_t*)(ws + WS_PROJ); bf16_t* U = (bf16_t*)(ws + WS_U); bf16_t* O = (bf16_t*)(ws + WS_O);
        u64* RSS = (u64*)(ws + WS_RSS);
        if (ph == 0) phase_init(p, shm_l);
        else {
            const int i = (ph - 1) / NPH_PER_LAYER, s = (ph - 1) % NPH_PER_LAYER, j = i >> 1; const bool even = (i & 1) == 0;
            pg8::StaticOrder SO; pg8::Gemm g; g.M = NTOK;
            if (s == 0) {
                const int N = even ? 3072 : 5376;
                g.A = XH; g.Bt = W + (even ? WO_EIN + (size_t)j * 3072 * 1024 : WO_SIN + (size_t)j * 5376 * 1024); g.N = N; g.K = 1024;
                SO.init(NTOK, N, G, bid);
                EpiStore E; E.O = PROJ; E.ldc = N; E.rs0 = RSS + RSSN_OFF + (size_t)i * NTOK;
                pg8::gemm_phase<EpiStore>(lds_l, g, SO, E);
                const int r1 = SO.nwg % G;
                g.A = PB + (size_t)i * NTOK * 256; g.Bt = W + WO_U + (size_t)i * 1024 * 256; g.N = 1024; g.K = 256;
                SO.init(NTOK, 1024, G, (bid - r1 + G) % G);
                E.O = EB; E.ldc = 1024; E.rs0 = nullptr;
                pg8::gemm_phase<EpiStore>(lds_l, g, SO, E);
            } else if (s == 1) {
                if (even) { for (int u = bid; u < 1024; u += G) hgrn_prep_unit(p, j, u, shm_l); phase_conv_lru(p, j); } else phase_conv_ssm(p, j);
            } else if (s == 2) {
                if (even) {
                    if (bid < 32) hgrn_prompt_unit(p, j, bid >> 2, bid & 3, shm_l);
                    else {
                        g.A = U; g.Bt = W + WO_LRU + (size_t)j * 1024 * 512; g.N = 1024; g.K = 512; SO.init(NTOK, 1024, G - 32, bid - 32);
                        EpiLru E; E.LA = (float*)(p.ws + WS_ON); E.LBT = E.LA + (size_t)NTOK * 512; E.U = U; E.ba = p.in[I_LBA] + j * 512; E.bx = p.in[I_LBX] + j * 512; E.lam = p.in[I_LAM] + j * 512;
                        pg8::gemm_phase<EpiLru>(lds_l, g, SO, E);
                        xcd_barrier(xb2);
                        phase_even_scan(p, j, shm_l);
                    }
                } else phase_ssd(p, j, shm_l);
            } else if (s == 3) {
                ;
            } else if (s == 4 || s == 6) {
                EpiResid E; E.XH = XH;
                const u64* gss = nullptr; E.kr = nullptr;
                if (s == 4) { g.A = O; g.K = even ? 1024 : 2048; g.Bt = W + (even ? WO_EOUT + (size_t)j * 1024 * 1024 : WO_SOUT + (size_t)j * 1024 * 2048);
                    E.rss = RSS + (size_t)i * NTOK; }
                else { g.A = PROJ; g.K = 2816; g.Bt = W + WO_2 + (size_t)i * 1024 * 2816; E.rss = nullptr; }
                g.N = 1024; g.M = NPR; SO.init(NPR, 1024, G, bid);
                if (s == 4 && !even) {
                    gss = (const u64*)(p.ws + WS_RSS) + 8 * (size_t)NTOK + (size_t)j * NTOK * 4;
                    pg8::Unit u0; LAS float* kr = (LAS float*)(lds_l + KR_OFF);
                    if (SO.next(0, u0) && threadIdx.x < 256) { const size_t row = (size_t)u0.pm * 256 + threadIdx.x; float r[4];
#pragma unroll
                        for (int q = 0; q < 4; ++q) r[q] = rsqrtf((float)gss[(size_t)q * NTOK + row] * (FXI / 512.f) + EPSN);
                        kr[threadIdx.x * 4 + 0] = r[0] / r[1]; kr[threadIdx.x * 4 + 1] = r[1] / r[2]; kr[threadIdx.x * 4 + 2] = r[2] / r[3]; kr[threadIdx.x * 4 + 3] = r[3]; }
                    __syncthreads();
                    E.kr = kr;
                }
                pg8::gemm_phase<EpiResid>(lds_l, g, SO, E);
                { EpiSResid ES; ES.XH = XH; ES.rss = E.rss;
                  for (int tile = bid; tile < 256; tile += G) sample_gemm<EpiSResid>(shm_l, g.A + (size_t)NPR * g.K, g.Bt, g.K, tile, ES, gss); }
            } else if (s == 5) {
                g.A = XH; g.Bt = W + WO_13 + (size_t)i * 5632 * 1024; g.N = 5632; g.K = 1024; SO.init(NTOK, 5632, G, bid);
                EpiSwiglu E; E.ACT = PROJ; E.rss = RSS + (size_t)i * NTOK;
                pg8::gemm_phase<EpiSwiglu>(lds_l, g, SO, E);
            } else if (s == 7) {
                g.A = XH; g.Bt = W + WO_G + (size_t)i * 1024 * 1024; g.N = 1024; g.K = 1024; g.M = NPR; SO.init(NPR, 1024, G, bid);
                EpiPle E; E.XH = XH; E.EB = EB; E.rss = RSS + (size_t)(4 + i) * NTOK; E.rsn = RSS + RSSN_OFF + (size_t)(i + 1) * NTOK; E.gp = p.in[I_GPLE] + (size_t)i * 1024;
                E.cnt = (unsigned*)(RSS + CNT_OFF) + i * 128;
                pg8::gemm_phase<EpiPle>(lds_l, g, SO, E);
                { EpiSPle ES; ES.XH = XH; ES.EB = EB; ES.rss = E.rss; ES.rsn = E.rsn; ES.gp = E.gp; ES.cnt = E.cnt;
                  for (int tile = bid; tile < 256; tile += G) sample_gemm<EpiSPle>(shm_l, g.A + (size_t)NPR * g.K, g.Bt, g.K, tile, ES); }
            } else if (i == 3) phase_final(p);
        }
        if (ph > 0 && ((ph - 1) % NPH_PER_LAYER == 3 || ((ph - 1) % NPH_PER_LAYER == 8 && ph + 1 < NPHASES))) continue;
        if (ph + 1 < ph_hi) { if (ph == ph_lo) { grid.sync(); xb = xcd_barrier_post(bar, st, gridDim.x); if (blockIdx.x >= 32) xb2 = xcd_barrier_post(bar + XCD_BAR_WORDS, st + 2, gridDim.x - 32); } else xcd_barrier(xb); }
    }
}

extern "C" void kernel_launch(void* const* d_in, const int* in_sizes, int n_in, void* d_out, int out_size, void* d_ws, size_t ws_size, hipStream_t stream) {
    static int grid = 0;
    if (grid == 0) {
        if (n_in != N_IN || (size_t)out_size != OO_END || ws_size < WS_END) { fprintf(stderr, "kernel_launch: unexpected shapes: n_in %d out %d ws %zu (need %zu)\n", n_in, out_size, ws_size, (size_t)WS_END); grid = -1; return; }
        int dev = 0, cus = 0, per_cu = 0;
        (void)hipGetDevice(&dev); (void)hipDeviceGetAttribute(&cus, hipDeviceAttributeMultiprocessorCount, dev);
        if (hipFuncSetAttribute((const void*)mega, hipFuncAttributeMaxDynamicSharedMemorySize, LDS_BYTES) != hipSuccess) { fprintf(stderr, "kernel_launch: hipFuncSetAttribute failed\n"); grid = -1; return; }
        if (hipOccupancyMaxActiveBlocksPerMultiprocessor(&per_cu, (const void*)mega, 512, LDS_BYTES) != hipSuccess || per_cu < 1) { fprintf(stderr, "kernel_launch: occupancy query failed (%d)\n", per_cu); (void)hipGetLastError(); per_cu = 1; }
        grid = cus * 1;
    }
    if (grid < 0) return;
    Params P; memset(&P, 0, sizeof(P));
    for (int i = 0; i < N_IN; ++i) P.in[i] = (const float*)d_in[i];
    P.out = (float*)d_out; P.ws = (unsigned char*)d_ws;
    P.ph_lo = 0; P.ph_hi = NPHASES;
    void* args[] = {&P};
    hipError_t e = hipLaunchCooperativeKernel((const void*)mega, dim3(grid), dim3(512), args, LDS_BYTES, stream);
    if (e != hipSuccess) fprintf(stderr, "kernel_launch: cooperative launch failed: %s (grid %d)\n", hipGetErrorString(e), grid);
}
```

```cpp
#include <hip/hip_runtime.h>
#include <hip/hip_cooperative_groups.h>
#include <cstdio>
#include <cstring>
namespace cg = cooperative_groups;

#define LAS __attribute__((address_space(3)))
typedef unsigned short bf16_t;
typedef short bf16x8 __attribute__((ext_vector_type(8)));
typedef float f32x4 __attribute__((ext_vector_type(4)));
typedef unsigned u32x4 __attribute__((ext_vector_type(4)));
typedef unsigned u32x2 __attribute__((ext_vector_type(2)));

constexpr int NTOK = 17408, NPR = 16384, DM = 1024, NSEQ = 136;
constexpr int KR_OFF = 131072 + 16;
constexpr int LDS_BYTES = 131072 + 16 + 4096;
constexpr float EPSN = 1e-6f;
constexpr int NPH_PER_LAYER = 9, NPHASES = 1 + 4 * NPH_PER_LAYER;

constexpr size_t WO_EIN = 0;
constexpr size_t WO_EOUT = WO_EIN + 2ull * 3072 * 1024;
constexpr size_t WO_SIN = WO_EOUT + 2ull * 1024 * 1024;
constexpr size_t WO_SOUT = WO_SIN + 2ull * 5376 * 1024;
constexpr size_t WO_13 = WO_SOUT + 2ull * 1024 * 2048;
constexpr size_t WO_2 = WO_13 + 4ull * 5632 * 1024;
constexpr size_t WO_G = WO_2 + 4ull * 1024 * 2816;
constexpr size_t WO_U = WO_G + 4ull * 1024 * 1024;
constexpr size_t WO_LRU = WO_U + 4ull * 1024 * 256;
constexpr size_t WO_END = WO_LRU + 2ull * 1024 * 512;

constexpr size_t al(size_t x) { return (x + 4095) & ~(size_t)4095; }
constexpr size_t WS_W = 0;
constexpr size_t WS_X = al(WS_W + WO_END * 2);
constexpr size_t WS_XN = al(WS_X + (size_t)NTOK * 4);
constexpr size_t WS_XB1 = al(WS_XN + (size_t)NTOK * 1024 * 2);
constexpr size_t WS_XB2 = al(WS_XB1 + (size_t)NTOK * 1024 * 2);
constexpr size_t WS_EB = al(WS_XB2 + (size_t)NTOK * 1024 * 2);
constexpr size_t WS_T = al(WS_EB + (size_t)NTOK * 1024 * 2);
constexpr size_t WS_PB = al(WS_T + (size_t)NTOK * 1024 * 2);
constexpr size_t WS_PROJ = al(WS_PB + 4ull * NTOK * 256 * 2);
constexpr size_t WS_U = al(WS_PROJ + (size_t)NTOK * 5376 * 2);
constexpr size_t WS_O = al(WS_U + (size_t)NTOK * 3072 * 2);
constexpr size_t WS_ON = al(WS_O + (size_t)NTOK * 2048 * 2);
constexpr size_t WS_DT = al(WS_ON + (size_t)NTOK * 2048 * 2);
constexpr size_t WS_RSS = al(WS_DT + (size_t)NTOK * 32 * 4 * 2);
constexpr size_t RSS_FLOATS = (size_t)NTOK * 21 + 512;
constexpr size_t RSSN_OFF = (size_t)NTOK * 16, CNT_OFF = (size_t)NTOK * 21;
constexpr size_t WS_HP = al(WS_RSS + RSS_FLOATS * 8);
constexpr size_t HP_UNIT = 4 * 16384 + 1024;
constexpr size_t WS_BAR = al(WS_HP + 1024 * HP_UNIT);
constexpr size_t WS_END = al(WS_BAR + 2 * 3456 * 4);
typedef unsigned long long u64;
constexpr float FXS = 16777216.f, FXI = 1.f / 16777216.f;

constexpr size_t OO_Y = 0;
constexpr size_t OO_HGP = OO_Y + (size_t)NTOK * 1024;
constexpr size_t OO_HGS = OO_HGP + 2ull * 8 * 4 * 128 * 128;
constexpr size_t OO_LHP = OO_HGS + 2ull * 128 * 4 * 128 * 128;
constexpr size_t OO_LHS = OO_LHP + 2ull * 8 * 512;
constexpr size_t OO_LCP = OO_LHS + 2ull * 128 * 512;
constexpr size_t OO_LCS = OO_LCP + 2ull * 8 * 3 * 512;
constexpr size_t OO_SSP = OO_LCS + 2ull * 128 * 3 * 512;
constexpr size_t OO_SSS = OO_SSP + 2ull * 8 * 32 * 64 * 128;
constexpr size_t OO_SCP = OO_SSS + 2ull * 128 * 32 * 64 * 128;
constexpr size_t OO_SCS = OO_SCP + 2ull * 8 * 3 * 3072;
constexpr size_t OO_END = OO_SCS + 2ull * 128 * 3 * 3072;

enum { I_XP = 0, I_XS, I_SHG, I_SLH, I_SLC, I_SSM, I_SSC, I_PP, I_PS, I_GMIX, I_GFFN, I_GPLE, I_GFIN, I_WEIN, I_HLB, I_HGN, I_LCW, I_LCB, I_LWA, I_LBA, I_LWX, I_LBX,
       I_LAM, I_WEOUT, I_SIN, I_SCW, I_SCB, I_SDTB, I_SALOG, I_SD, I_SGN, I_SOUT, I_W1, I_W3, I_W2, I_PUP, I_PGATE, N_IN };

struct Params {
    const float* in[N_IN];
    float* out;
    unsigned char* ws;
    int ph_lo, ph_hi;
};
typedef const Params __attribute__((address_space(4))) KParams;

#define LDSBAR() do { asm volatile("s_waitcnt lgkmcnt(0)" ::: "memory"); __builtin_amdgcn_s_barrier(); asm volatile("" ::: "memory"); } while (0)
__device__ __forceinline__ int tid_opaque() { int t = threadIdx.x; asm volatile("" : "+v"(t)); return t; }
__device__ __forceinline__ int tid_opaque_dep(int dep) { int t = threadIdx.x; asm volatile("" : "+v"(t) : "s"(dep)); return t; }
__device__ __forceinline__ int bid_opaque() { int b = blockIdx.x; asm volatile("" : "+s"(b)); return b; }
__device__ __forceinline__ unsigned cvt_pk_bf16(float lo, float hi) { unsigned r; asm volatile("v_cvt_pk_bf16_f32 %0, %1, %2" : "=v"(r) : "v"(lo), "v"(hi)); return r; }
__device__ __forceinline__ bf16_t f2bf(float f) { unsigned u = __float_as_uint(f); u += 0x7fffu + ((u >> 16) & 1u); return (bf16_t)(u >> 16); }
__device__ __forceinline__ float bf2f(bf16_t h) { return __uint_as_float(((unsigned)h) << 16); }
__device__ __forceinline__ float bflo(unsigned w) { return __uint_as_float(w << 16); }
__device__ __forceinline__ float bfhi(unsigned w) { return __uint_as_float(w & 0xffff0000u); }
__device__ __forceinline__ float sigmoidf_(float x) { return __builtin_amdgcn_rcpf(1.f + __expf(-x)); }
__device__ __forceinline__ float siluf_(float x) { return x * sigmoidf_(x); }
__device__ __forceinline__ float geluf_(float x) { const float u = 0.7978845608028654f * (x + 0.044715f * x * x * x); const float t = 1.f - 2.f * __builtin_amdgcn_rcpf(__expf(2.f * u) + 1.f); return 0.5f * x * (1.f + t); }
__device__ __forceinline__ float softplusf_(float x) { return x > 20.f ? x : log1pf(__expf(x)); }
__device__ __forceinline__ float wave_sum(float v) {
#pragma unroll
    for (int o = 32; o > 0; o >>= 1) v += __shfl_xor(v, o);
    return v;
}


#define XB_TMO      128
#define XB_XCNT(j)  (256  + 64 * (j))
#define XB_XSUB(j)  (1280 + 64 * (j))
#define XB_XGEN(j)  (2304 + 64 * (j))
#define XB_TOP      3328
#define XB_TOPGEN   3392
#define XCD_BAR_WORDS 3456
#define XB_SPIN_CAP (1u << 22)
__device__ __forceinline__ unsigned xb_ld(unsigned* p)              { return __hip_atomic_load(p, __ATOMIC_RELAXED, __HIP_MEMORY_SCOPE_AGENT); }
__device__ __forceinline__ unsigned xb_add(unsigned* p, unsigned v) { return __hip_atomic_fetch_add(p, v, __ATOMIC_RELAXED, __HIP_MEMORY_SCOPE_AGENT); }
__device__ __forceinline__ unsigned xb_xcc_id() { return (unsigned)__builtin_amdgcn_s_getreg((3 << 11) | 20) & 0xFu; }
#define XB_SPIN(cond, bar) do { unsigned _sp = 0; while (cond) { __builtin_amdgcn_s_sleep(1); \
    if ((++_sp & 255u) == 0u) { if (xb_ld(&(bar)[XB_TMO])) break; if (_sp > XB_SPIN_CAP) { atomicAdd(&(bar)[XB_TMO], 1u); break; } } } } while (0)
struct XcdBarrier { unsigned* bar; unsigned x; volatile LAS unsigned* st; unsigned expect; };
__device__ __forceinline__ XcdBarrier xcd_barrier_post(unsigned* bar, volatile LAS unsigned* st, unsigned expect) {
    XcdBarrier b; b.bar = bar; b.x = xb_xcc_id(); b.st = st; b.expect = expect;
    if (threadIdx.x == 0) (void)xb_add(&bar[XB_XCNT(b.x)], 1u);
    return b;
}
__device__ __forceinline__ void xcd_barrier_complete(unsigned* bar, unsigned x, unsigned& nloc, unsigned& nx, unsigned G) {
    unsigned sum, cnt, mine, sp = 0u;
    for (;;) {
        sum = 0u; cnt = 0u; mine = 0u;
#pragma unroll
        for (unsigned j = 0; j < 16; ++j) { const unsigned c = xb_ld(&bar[XB_XCNT(j)]); sum += c; cnt += (c > 0u) ? 1u : 0u; mine = (j == x) ? c : mine; }
        if (sum == G) break;
        __builtin_amdgcn_s_sleep(1);
        if ((++sp & 255u) == 0u) { if (xb_ld(&bar[XB_TMO])) break; if (sp > XB_SPIN_CAP) { atomicAdd(&bar[XB_TMO], 1u); break; } }
    }
    nloc = mine > 0u ? mine : 1u; nx = cnt > 0u ? cnt : 1u;
}
__device__ __forceinline__ void xcd_barrier(const XcdBarrier& b) {
    asm volatile("s_waitcnt vmcnt(0)" ::: "memory");
    __syncthreads();
    if (threadIdx.x == 0) {
        unsigned* bar = b.bar;
        __builtin_amdgcn_s_waitcnt(0);
        unsigned nloc = b.st[0], nx = b.st[1];
        if (nloc == 0u) { xcd_barrier_complete(bar, b.x, nloc, nx, b.expect); b.st[0] = nloc; b.st[1] = nx; }
        const unsigned old = xb_add(&bar[XB_XSUB(b.x)], 1u);
        const unsigned gen = old / nloc;
        if (old + 1u == (gen + 1u) * nloc) {
            __builtin_amdgcn_fence(__ATOMIC_RELEASE, "agent");
            asm volatile("s_waitcnt vmcnt(0)" ::: "memory");
            const unsigned og = xb_add(&bar[XB_TOP], 1u);
            const unsigned tg = og / nx;
            if (og + 1u == (tg + 1u) * nx) xb_add(&bar[XB_TOPGEN], 1u);
            else XB_SPIN(xb_ld(&bar[XB_TOPGEN]) == tg, bar);
            __builtin_amdgcn_fence(__ATOMIC_ACQUIRE, "agent");
            xb_add(&bar[XB_XGEN(b.x)], 1u);
            asm volatile("s_waitcnt vmcnt(0)" ::: "memory");
        } else {
            XB_SPIN(xb_ld(&bar[XB_XGEN(b.x)]) == gen, bar);
            __builtin_amdgcn_fence(__ATOMIC_ACQUIRE, "agent");
            asm volatile("s_waitcnt vmcnt(0)" ::: "memory");
        }
    }
    __syncthreads();
}

namespace pg8 {
constexpr int BM = 256, BK = 64, HALF = 128, HTB = HALF * BK * 2, STAGE_BYTES = 8 * HTB, NXCD = 8, WGM = 8;
__host__ __device__ __forceinline__ int lds_byte(int r, int c) { const int st = (r >> 4) * 2 + (c >> 5), rr = r & 15, cc = c & 31, ob = rr * 64 + cc * 2; return st * 1024 + (ob ^ (((ob >> 9) & 1) << 5)); }
__host__ __device__ __forceinline__ void stage_rc(int b, int& R, int& C) { const int st = b / 1024, sb = b % 1024, swz = sb ^ (((sb >> 9) & 1) << 5); R = (st >> 1) * 16 + swz / 64; C = (st & 1) * 32 + (swz % 64) / 2; }
__host__ __device__ __forceinline__ int perm32(int rho) { const int n = rho >> 4, i = rho & 15; return 8 * (i >> 2) + 4 * n + (i & 3); }
struct Unit { int pm, pn; };
struct Gemm { const bf16_t* A; const bf16_t* Bt; int M, N, K; };
struct StaticOrder {
    int nM, nN, nwg, G, c;
    __device__ void init(int M, int N, int G_, int c_) { nM = M / BM; nN = N / BM; nwg = nM * nN; G = G_; c = c_; }
    __device__ bool next(int i, Unit& u) const {
        const long L = (long)i * G + c; if (L >= nwg) return false;
        int wgid = (int)L; { const int q = nwg / NXCD, r = nwg % NXCD, xcd = wgid % NXCD, off = wgid / NXCD; wgid = (xcd < r ? xcd * (q + 1) : r * (q + 1) + (xcd - r) * q) + off; }
        const int nig = WGM * nN, gid = wgid / nig, fm = gid * WGM, gsz = (nM - fm) < WGM ? (nM - fm) : WGM;
        u.pm = fm + ((wgid % nig) % gsz); u.pn = (wgid % nig) / gsz; return true;
    }
};

template <class Epi>
__device__ __forceinline__ void gemm_phase(LAS unsigned char* lds, const Gemm g, const StaticOrder& S, const Epi& E) {
    const int tid = tid_opaque(), wid = __builtin_amdgcn_readfirstlane(tid >> 6), lane = tid & 63, wr = wid >> 2, wc = wid & 3, fr = lane & 15, fq = lane >> 4;
    const int K = g.K, nt = K / BK;
    unsigned voffA[2], voffB[2];
#pragma unroll
    for (int i = 0; i < 2; ++i) { int R, C; stage_rc(tid * 16 + i * 8192, R, C); const int Rb = Epi::PERM ? ((R & ~31) + perm32(R & 31)) : R;
        voffA[i] = (unsigned)(R * K + C) * 2u; voffB[i] = (unsigned)(Rb * K + C) * 2u; }
    const size_t kstep = (size_t)(BK * 2);
    const size_t hstep = (size_t)HALF * K * 2;
    const size_t tstep = 2 * hstep;
    const unsigned ldsw = (unsigned)wid * 1024u;
    const int aoff = lds_byte(wr * 64 + fr, fq * 8), boff = lds_byte(wc * 32 + fr, fq * 8);
#define PG8_SA(b, h) (((b) * 2 + (h)) * HTB)
#define PG8_SB(b, h) ((4 + (b) * 2 + (h)) * HTB)
#define PG8_STAGE(bufoff, gbase, voff) do { _Pragma("unroll") for (int _i = 0; _i < 2; ++_i) \
        __builtin_amdgcn_global_load_lds((const unsigned*)((const char*)(gbase) + (voff)[_i]), (LAS unsigned*)(lds + (bufoff) + ldsw + _i * 8192), 16, 0, 0); } while (0)
#define PG8_LDA(dst, b, h) do { _Pragma("unroll") for (int m = 0; m < 4; ++m) _Pragma("unroll") for (int k = 0; k < 2; ++k) dst[m][k] = *(const LAS bf16x8*)(lds + PG8_SA(b, h) + aoff + m * 2048 + k * 1024); } while (0)
#define PG8_LDB(dst, b, h) do { _Pragma("unroll") for (int n = 0; n < 2; ++n) _Pragma("unroll") for (int k = 0; k < 2; ++k) dst[n][k] = *(const LAS bf16x8*)(lds + PG8_SB(b, h) + boff + n * 2048 + k * 1024); } while (0)
#define PG8_MMA(ai, bj, At, Bt) do { __builtin_amdgcn_s_setprio(1); _Pragma("unroll") for (int m = 0; m < 4; ++m) _Pragma("unroll") for (int n = 0; n < 2; ++n) _Pragma("unroll") for (int k = 0; k < 2; ++k) \
        acc[ai][bj][m][n] = __builtin_amdgcn_mfma_f32_16x16x32_bf16(Bt[n][k], At[m][k], acc[ai][bj][m][n], 0, 0, 0); __builtin_amdgcn_s_setprio(0); } while (0)
#define PG8_WAIT_V(n) asm volatile("s_waitcnt vmcnt(" #n ")" ::: "memory")
#define PG8_WAIT_L(n) asm volatile("s_waitcnt lgkmcnt(" #n ")" ::: "memory")
#define PG8_BAR __builtin_amdgcn_s_barrier()
#define PG8_SCHED __builtin_amdgcn_sched_barrier(0)
    Unit cur, nxt; int ui = 0;
    if (!S.next(0, cur)) return;
    f32x4 acc[2][2][4][2];
#pragma unroll
    for (int a = 0; a < 2; ++a)
#pragma unroll
        for (int b = 0; b < 2; ++b)
#pragma unroll
            for (int m = 0; m < 4; ++m)
#pragma unroll
                for (int n = 0; n < 2; ++n) acc[a][b][m][n] = (f32x4){0.f, 0.f, 0.f, 0.f};
    bf16x8 At[4][2], B0[2][2], B1[2][2];
    const char* cA = (const char*)g.A + (size_t)cur.pm * tstep; const char* cB = (const char*)g.Bt + (size_t)cur.pn * tstep;
    PG8_STAGE(PG8_SB(0, 0), cB, voffB); PG8_STAGE(PG8_SA(0, 0), cA, voffA); PG8_STAGE(PG8_SB(0, 1), cB + hstep, voffB); PG8_STAGE(PG8_SA(0, 1), cA + hstep, voffA);
    if (wr == 1) PG8_BAR;
    PG8_WAIT_V(4); PG8_BAR;
    PG8_STAGE(PG8_SB(1, 0), cB + kstep, voffB); PG8_STAGE(PG8_SA(1, 0), cA + kstep, voffA); PG8_STAGE(PG8_SB(1, 1), cB + hstep + kstep, voffB);
    PG8_WAIT_V(6); PG8_BAR;
    for (;;) {
        const bool has_next = S.next(ui + 1, nxt);
        const char* nA = has_next ? (const char*)g.A + (size_t)nxt.pm * tstep : cA; const char* nB = has_next ? (const char*)g.Bt + (size_t)nxt.pn * tstep : cB;
        int tseg = nt; if constexpr (Epi::KSCALE) { if (E.kr) tseg = 8; }
        for (int t0 = 0; t0 < nt; t0 += tseg) {
        if (Epi::KSCALE && t0 > 0) {
            const unsigned kaddr = (unsigned)(size_t)lds + (unsigned)KR_OFF + (unsigned)((wr * 64 + fr) * 16 + ((t0 >> 3) - 1) * 4);
#define PG8_KS(a_, m_) do { float rr_; asm volatile("ds_read_b32 %0, %1 offset:%2\n\ts_waitcnt lgkmcnt(0)" : "=v"(rr_) : "v"(kaddr), "n"(((a_) * 128 + (m_) * 16) * 16) : "memory"); \
                acc[a_][0][m_][0] = acc[a_][0][m_][0] * rr_; acc[a_][0][m_][1] = acc[a_][0][m_][1] * rr_; acc[a_][1][m_][0] = acc[a_][1][m_][0] * rr_; acc[a_][1][m_][1] = acc[a_][1][m_][1] * rr_; } while (0)
            PG8_KS(0, 0); PG8_KS(0, 1); PG8_KS(0, 2); PG8_KS(0, 3); PG8_KS(1, 0); PG8_KS(1, 1); PG8_KS(1, 2); PG8_KS(1, 3);
#undef PG8_KS
        }
        for (int t = t0; t < t0 + tseg; t += 2) {
            const bool last = (t == nt - 2);
            const char* a1 = cA + (size_t)(t + 1) * kstep;
            const char* a2 = last ? nA : cA + (size_t)(t + 2) * kstep; const char* b2 = last ? nB : cB + (size_t)(t + 2) * kstep;
            const char* a3 = a2 + kstep; const char* b3 = b2 + kstep;
            PG8_LDB(B0, 0, 0); PG8_SCHED; PG8_LDA(At, 0, 0); PG8_STAGE(PG8_SA(1, 1), a1 + hstep, voffA);
            PG8_WAIT_L(8); PG8_BAR; PG8_WAIT_L(0); PG8_MMA(0, 0, At, B0); PG8_BAR; PG8_SCHED;
            PG8_LDB(B1, 0, 1); PG8_STAGE(PG8_SB(0, 0), b2, voffB);
            PG8_BAR; PG8_WAIT_L(0); PG8_MMA(0, 1, At, B1); PG8_BAR;
            PG8_LDA(At, 0, 1); PG8_STAGE(PG8_SA(0, 0), a2, voffA);
            PG8_BAR; PG8_WAIT_L(0); PG8_MMA(1, 0, At, B0); PG8_BAR; PG8_SCHED;
            PG8_STAGE(PG8_SB(0, 1), b2 + hstep, voffB);
            PG8_WAIT_V(6); PG8_BAR; PG8_MMA(1, 1, At, B1); PG8_BAR;
            PG8_LDB(B0, 1, 0); PG8_SCHED; PG8_LDA(At, 1, 0); PG8_STAGE(PG8_SA(0, 1), a2 + hstep, voffA);
            PG8_WAIT_L(8); PG8_BAR; PG8_WAIT_L(0); PG8_MMA(0, 0, At, B0); PG8_BAR; PG8_SCHED;
            PG8_LDB(B1, 1, 1); PG8_STAGE(PG8_SB(1, 0), b3, voffB);
            PG8_BAR; PG8_WAIT_L(0); PG8_MMA(0, 1, At, B1); PG8_BAR;
            PG8_LDA(At, 1, 1); PG8_STAGE(PG8_SA(1, 0), a3, voffA);
            PG8_BAR; PG8_WAIT_L(0); PG8_MMA(1, 0, At, B0); PG8_BAR; PG8_SCHED;
            PG8_STAGE(PG8_SB(1, 1), b3 + hstep, voffB);
            PG8_WAIT_V(6); PG8_BAR; PG8_MMA(1, 1, At, B1); PG8_BAR;
        }
        }
        if constexpr (!Epi::AFTER_DRAIN) E(acc, cur, wr, wc, fr, fq);
        if (!has_next) break;
#pragma unroll
        for (int a = 0; a < 2; ++a)
#pragma unroll
            for (int b = 0; b < 2; ++b)
#pragma unroll
                for (int m = 0; m < 4; ++m)
#pragma unroll
                    for (int n = 0; n < 2; ++n) acc[a][b][m][n] = (f32x4){0.f, 0.f, 0.f, 0.f};
        cur = nxt; cA = nA; cB = nB; ++ui;
    }
    PG8_WAIT_V(0);
    if (wr == 0) PG8_BAR;
    PG8_BAR;
    if constexpr (Epi::AFTER_DRAIN) E.fused(acc, cur, wr, wc, fr, fq);
#undef PG8_SA
#undef PG8_SB
#undef PG8_STAGE
#undef PG8_LDA
#undef PG8_LDB
#undef PG8_MMA
#undef PG8_WAIT_V
#undef PG8_WAIT_L
#undef PG8_BAR
#undef PG8_SCHED
}
}

struct EpiStore {
    static constexpr bool AFTER_DRAIN = false;
    static constexpr bool KSCALE = false;
    static constexpr bool PERM = true;
    bf16_t* O; int ldc; const u64* rs0;
    __device__ __forceinline__ void operator()(const f32x4 (&acc)[2][2][4][2], const pg8::Unit& u, int wr, int wc, int fr, int fq) const {
        const int row0 = u.pm * 256 + wr * 64 + fr, col0 = u.pn * 256 + wc * 32 + 8 * fq;
#pragma unroll
        for (int ai = 0; ai < 2; ++ai)
#pragma unroll
            for (int m = 0; m < 4; ++m) { bf16_t* rowp = O + (size_t)(row0 + ai * 128 + m * 16) * ldc + col0;
                const float r = rs0 ? rsqrtf((float)rs0[row0 + ai * 128 + m * 16] * (FXI / 1024.f) + EPSN) : 1.f;
#pragma unroll
                for (int bj = 0; bj < 2; ++bj) { const f32x4 v0 = acc[ai][bj][m][0] * r, v1 = acc[ai][bj][m][1] * r;
                    u32x4 w; w[0] = cvt_pk_bf16(v0[0], v0[1]); w[1] = cvt_pk_bf16(v0[2], v0[3]); w[2] = cvt_pk_bf16(v1[0], v1[1]); w[3] = cvt_pk_bf16(v1[2], v1[3]);
                    *(u32x4*)(rowp + bj * 128) = w; } }
    }
};
struct EpiResid {
    static constexpr bool AFTER_DRAIN = false;
    static constexpr bool PERM = true, KSCALE = true;
    bf16_t* XH; u64* rss; const LAS float* kr;
    __device__ __forceinline__ void operator()(const f32x4 (&acc)[2][2][4][2], const pg8::Unit& u, int wr, int wc, int fr, int fq) const {
        const int row0 = u.pm * 256 + wr * 64 + fr, col0 = u.pn * 256 + wc * 32 + 8 * fq;
#pragma unroll
        for (int ai = 0; ai < 2; ++ai)
#pragma unroll
            for (int m = 0; m < 4; ++m) { const int row = row0 + ai * 128 + m * 16; float ss = 0.f;
                const float rl = kr ? kr[(ai * 128 + wr * 64 + m * 16 + fr) * 4 + 3] : 1.f;
#pragma unroll
                for (int bj = 0; bj < 2; ++bj) { bf16_t* xp = XH + (size_t)row * 1024 + col0 + bj * 128; const u32x4 xw = *(const u32x4*)xp; u32x4 w;
#pragma unroll
                    for (int n = 0; n < 2; ++n) { const f32x4 a = acc[ai][bj][m][n] * rl;
                        const float x0 = bflo(xw[2 * n]) + a[0], x1 = bfhi(xw[2 * n]) + a[1], x2 = bflo(xw[2 * n + 1]) + a[2], x3 = bfhi(xw[2 * n + 1]) + a[3];
                        ss += x0 * x0 + x1 * x1 + x2 * x2 + x3 * x3; w[2 * n] = cvt_pk_bf16(x0, x1); w[2 * n + 1] = cvt_pk_bf16(x2, x3); }
                    *(u32x4*)xp = w; }
                if (rss) { ss += __shfl_xor(ss, 16); ss += __shfl_xor(ss, 32); if (fq == 0) atomicAdd(rss + row, (u64)(ss * FXS)); } }
    }
};
struct EpiSwiglu {
    static constexpr bool AFTER_DRAIN = false;
    static constexpr bool KSCALE = false;
    static constexpr bool PERM = true;
    bf16_t* ACT; const u64* rss;
    __device__ __forceinline__ void operator()(const f32x4 (&acc)[2][2][4][2], const pg8::Unit& u, int wr, int wc, int fr, int fq) const {
        const int row0 = u.pm * 256 + wr * 64 + fr, col0 = u.pn * 128 + wc * 32 + 8 * fq;
#pragma unroll
        for (int ai = 0; ai < 2; ++ai)
#pragma unroll
            for (int m = 0; m < 4; ++m) { const int row = row0 + ai * 128 + m * 16;
                const float r = rsqrtf((float)rss[row] * (FXI / 1024.f) + EPSN), r2 = r * r, rl = -1.44269504f * r;
                u32x4 w;
#pragma unroll
                for (int n = 0; n < 2; ++n) { const f32x4 a1 = acc[ai][0][m][n], a3 = acc[ai][1][m][n]; float o[4];
#pragma unroll
                    for (int q = 0; q < 4; ++q) o[q] = (a1[q] * a3[q]) * (r2 * __builtin_amdgcn_rcpf(1.f + __builtin_amdgcn_exp2f(a1[q] * rl)));
                    w[2 * n] = cvt_pk_bf16(o[0], o[1]); w[2 * n + 1] = cvt_pk_bf16(o[2], o[3]); }
                *(u32x4*)(ACT + (size_t)row * 2816 + col0) = w; }
    }
};
__device__ __forceinline__ void panel_wait(unsigned* cnt, unsigned need) {
    asm volatile("s_waitcnt vmcnt(0)" ::: "memory");
    __syncthreads();
    if (threadIdx.x == 0) { (void)xb_add(cnt, 1u); unsigned sp = 0u; while (xb_ld(cnt) < need) { __builtin_amdgcn_s_sleep(1); if (++sp > (1u << 22)) break; } }
    __syncthreads();
}
struct EpiPle {
    static constexpr bool KSCALE = false, PERM = true, AFTER_DRAIN = true;
    bf16_t* XH; const bf16_t* EB; u64* rss; u64* rsn; const float* gp; unsigned* cnt;
    __device__ __forceinline__ void fused(f32x4 (&acc)[2][2][4][2], const pg8::Unit& u, int wr, int wc, int fr, int fq) const {
        const int row0 = u.pm * 256 + wr * 64 + fr, col0 = u.pn * 256 + wc * 32 + 8 * fq;
#pragma unroll
        for (int ai = 0; ai < 2; ++ai)
#pragma unroll
            for (int m = 0; m < 4; ++m) { const int row = row0 + ai * 128 + m * 16; float ss = 0.f;
#pragma unroll
                for (int bj = 0; bj < 2; ++bj) { const u32x4 e = *(const u32x4*)(EB + (size_t)row * 1024 + col0 + bj * 128);
#pragma unroll
                    for (int n = 0; n < 2; ++n) { f32x4 v = acc[ai][bj][m][n];
                        v[0] = sigmoidf_(v[0]) * bflo(e[2 * n]); v[1] = sigmoidf_(v[1]) * bfhi(e[2 * n]); v[2] = sigmoidf_(v[2]) * bflo(e[2 * n + 1]); v[3] = sigmoidf_(v[3]) * bfhi(e[2 * n + 1]);
                        ss += v[0] * v[0] + v[1] * v[1] + v[2] * v[2] + v[3] * v[3]; acc[ai][bj][m][n] = v; } }
                ss += __shfl_xor(ss, 16); ss += __shfl_xor(ss, 32); if (fq == 0) atomicAdd(rss + row, (u64)(ss * FXS)); }
        panel_wait(cnt + u.pm, 4u);
#pragma unroll
        for (int ai = 0; ai < 2; ++ai)
#pragma unroll
            for (int m = 0; m < 4; ++m) { const int row = row0 + ai * 128 + m * 16; float ss = 0.f;
                const float rt = rsqrtf((float)__hip_atomic_load(rss + row, __ATOMIC_RELAXED, __HIP_MEMORY_SCOPE_AGENT) * (FXI / 1024.f) + EPSN);
#pragma unroll
                for (int bj = 0; bj < 2; ++bj) { bf16_t* xp = XH + (size_t)row * 1024 + col0 + bj * 128; const u32x4 xw = *(const u32x4*)xp; u32x4 w;
#pragma unroll
                    for (int n = 0; n < 2; ++n) { const f32x4 t = acc[ai][bj][m][n], gg = *(const f32x4*)(gp + col0 + bj * 128 + 4 * n);
                        const float x0 = bflo(xw[2 * n]) + t[0] * rt * gg[0], x1 = bfhi(xw[2 * n]) + t[1] * rt * gg[1], x2 = bflo(xw[2 * n + 1]) + t[2] * rt * gg[2], x3 = bfhi(xw[2 * n + 1]) + t[3] * rt * gg[3];
                        ss += x0 * x0 + x1 * x1 + x2 * x2 + x3 * x3; w[2 * n] = cvt_pk_bf16(x0, x1); w[2 * n + 1] = cvt_pk_bf16(x2, x3); }
                    *(u32x4*)xp = w; }
                ss += __shfl_xor(ss, 16); ss += __shfl_xor(ss, 32); if (fq == 0) atomicAdd(rsn + row, (u64)(ss * FXS)); }
    }
};
struct EpiLru {
    static constexpr bool AFTER_DRAIN = false;
    static constexpr bool KSCALE = false;
    static constexpr bool PERM = false;
    float* LA; float* LBT; const bf16_t* U; const float* ba; const float* bx; const float* lam;
    __device__ __forceinline__ void operator()(const f32x4 (&acc)[2][2][4][2], const pg8::Unit& u, int wr, int wc, int fr, int fq) const {
        const int row0 = u.pm * 256 + wr * 64 + fr, ch0 = u.pn * 128 + wc * 32 + 4 * fq;
#pragma unroll
        for (int n = 0; n < 2; ++n) { const int ch = ch0 + n * 16;
            const f32x4 bav = *(const f32x4*)(ba + ch), bxv = *(const f32x4*)(bx + ch), lmv = *(const f32x4*)(lam + ch);
            f32x4 sp;
#pragma unroll
            for (int q = 0; q < 4; ++q) sp[q] = -8.f * softplusf_(-lmv[q]);
#pragma unroll
            for (int ai = 0; ai < 2; ++ai)
#pragma unroll
                for (int m = 0; m < 4; ++m) { const int row = row0 + ai * 128 + m * 16;
                    const bool first = (row < NPR) && ((row & 2047) == 0);
                    const u32x2 uw = *(const u32x2*)(U + (size_t)row * 512 + ch);
                    const float uu[4] = {bflo(uw[0]), bfhi(uw[0]), bflo(uw[1]), bfhi(uw[1])};
                    f32x4 av, bv;
#pragma unroll
                    for (int q = 0; q < 4; ++q) { const float r = sigmoidf_(acc[ai][0][m][n][q] + bav[q]), gi = sigmoidf_(acc[ai][1][m][n][q] + bxv[q]);
                        const float la = sp[q] * r; av[q] = __expf(la); const float x2 = 2.f * la;
                        const float em = x2 > -0.25f ? -x2 * (1.f + x2 * (0.5f + x2 * (0.16666667f + x2 * (0.041666668f + x2 * 0.0083333338f)))) : 1.f - __expf(x2);
                        const float mult = first ? 1.f : __builtin_amdgcn_sqrtf(em); bv[q] = mult * gi * uu[q]; }
                    *(f32x4*)(LA + (size_t)row * 512 + ch) = av; *(f32x4*)(LBT + (size_t)row * 512 + ch) = bv; }
        }
    }
};


template <class EpiS>
__device__ __forceinline__ void sample_gemm(unsigned char* shm, const bf16_t* A, const bf16_t* Bt, int K, int tile, const EpiS& E, const u64* gss = nullptr) {
    const int tid = tid_opaque(), lane = tid & 63, wid = tid >> 6, fr = lane & 15, fq = lane >> 4, wr = wid >> 2, wc = wid & 3;
    const int tm = tile >> 4, tn = tile & 15;
    constexpr int PIT = 136;
    bf16_t* sA = (bf16_t*)shm; bf16_t* sB = sA + 2 * 64 * PIT;
    const int lrow = tid >> 3, lc8 = (tid & 7) * 8;
    const bf16_t* gA = A + (size_t)(tm * 64 + lrow) * K + lc8;
    const bf16_t* gB = Bt + (size_t)(tn * 64 + lrow) * K + lc8;
    f32x4 acc[2]; acc[0] = (f32x4){0.f, 0.f, 0.f, 0.f}; acc[1] = acc[0];
    u32x4 ra0 = *(const u32x4*)gA, ra1 = *(const u32x4*)(gA + 64), rb0 = *(const u32x4*)gB, rb1 = *(const u32x4*)(gB + 64);
    const int nk = K >> 7;
    LDSBAR();
    for (int kt = 0; kt < nk; ++kt) {
        bf16_t* bA = sA + (kt & 1) * 64 * PIT; bf16_t* bB = sB + (kt & 1) * 64 * PIT;
        *(u32x4*)(bA + lrow * PIT + lc8) = ra0; *(u32x4*)(bA + lrow * PIT + 64 + lc8) = ra1; *(u32x4*)(bB + lrow * PIT + lc8) = rb0; *(u32x4*)(bB + lrow * PIT + 64 + lc8) = rb1;
        LDSBAR();
        if (kt + 1 < nk) { const size_t o = (size_t)(kt + 1) * 128; ra0 = *(const u32x4*)(gA + o); ra1 = *(const u32x4*)(gA + o + 64); rb0 = *(const u32x4*)(gB + o); rb1 = *(const u32x4*)(gB + o + 64); }
        if (gss && kt > 0 && (kt & 3) == 0) { const int gi = (kt >> 2) - 1;
#pragma unroll
            for (int m = 0; m < 2; ++m) { const size_t row = NPR + tm * 64 + wr * 32 + m * 16 + fr;
                const float r0 = rsqrtf((float)gss[(size_t)gi * NTOK + row] * (FXI / 512.f) + EPSN), r1 = rsqrtf((float)gss[(size_t)(gi + 1) * NTOK + row] * (FXI / 512.f) + EPSN);
                acc[m] = acc[m] * (r0 / r1); } }
#pragma unroll
        for (int ks = 0; ks < 4; ++ks) { const bf16x8 bfg = *(const bf16x8*)(bB + (wc * 16 + fr) * PIT + ks * 32 + fq * 8);
#pragma unroll
            for (int m = 0; m < 2; ++m) acc[m] = __builtin_amdgcn_mfma_f32_16x16x32_bf16(bfg, *(const bf16x8*)(bA + (wr * 32 + m * 16 + fr) * PIT + ks * 32 + fq * 8), acc[m], 0, 0, 0); }
    }
    LDSBAR();
    if (gss) {
#pragma unroll
        for (int m = 0; m < 2; ++m) { const size_t row = NPR + tm * 64 + wr * 32 + m * 16 + fr; acc[m] = acc[m] * rsqrtf((float)gss[3 * (size_t)NTOK + row] * (FXI / 512.f) + EPSN); } }
    E(acc, NPR + tm * 64 + wr * 32 + fr, tn * 64 + wc * 16 + 4 * fq, fq);
}
struct EpiSResid {
    bf16_t* XH; u64* rss;
    __device__ __forceinline__ void operator()(const f32x4 (&acc)[2], int row0, int col0, int fq) const {
#pragma unroll
        for (int m = 0; m < 2; ++m) { const int row = row0 + m * 16; bf16_t* xp = XH + (size_t)row * 1024 + col0;
            const u32x2 xw = *(const u32x2*)xp;
            const float x0 = bflo(xw[0]) + acc[m][0], x1 = bfhi(xw[0]) + acc[m][1], x2 = bflo(xw[1]) + acc[m][2], x3 = bfhi(xw[1]) + acc[m][3];
            float ss = x0 * x0 + x1 * x1 + x2 * x2 + x3 * x3;
            u32x2 w; w[0] = cvt_pk_bf16(x0, x1); w[1] = cvt_pk_bf16(x2, x3); *(u32x2*)xp = w;
            if (rss) { ss += __shfl_xor(ss, 16); ss += __shfl_xor(ss, 32); if (fq == 0) atomicAdd(rss + row, (u64)(ss * FXS)); } }
    }
};
struct EpiSPle {
    bf16_t* XH; const bf16_t* EB; u64* rss; u64* rsn; const float* gp; unsigned* cnt;
    __device__ __forceinline__ void operator()(f32x4 (&acc)[2], int row0, int col0, int fq) const {
#pragma unroll
        for (int m = 0; m < 2; ++m) { const int row = row0 + m * 16; const u32x2 e = *(const u32x2*)(EB + (size_t)row * 1024 + col0);
            f32x4 v = acc[m];
            v[0] = sigmoidf_(v[0]) * bflo(e[0]); v[1] = sigmoidf_(v[1]) * bfhi(e[0]); v[2] = sigmoidf_(v[2]) * bflo(e[1]); v[3] = sigmoidf_(v[3]) * bfhi(e[1]);
            float ss = v[0] * v[0] + v[1] * v[1] + v[2] * v[2] + v[3] * v[3]; acc[m] = v;
            ss += __shfl_xor(ss, 16); ss += __shfl_xor(ss, 32); if (fq == 0) atomicAdd(rss + row, (u64)(ss * FXS)); }
        panel_wait(cnt + 64 + ((row0 - NPR) >> 6), 16u);
        const f32x4 gg = *(const f32x4*)(gp + col0);
#pragma unroll
        for (int m = 0; m < 2; ++m) { const int row = row0 + m * 16; bf16_t* xp = XH + (size_t)row * 1024 + col0; const u32x2 xw = *(const u32x2*)xp;
            const float rt = rsqrtf((float)__hip_atomic_load(rss + row, __ATOMIC_RELAXED, __HIP_MEMORY_SCOPE_AGENT) * (FXI / 1024.f) + EPSN);
            const f32x4 t = acc[m];
            const float x0 = bflo(xw[0]) + t[0] * rt * gg[0], x1 = bfhi(xw[0]) + t[1] * rt * gg[1], x2 = bflo(xw[1]) + t[2] * rt * gg[2], x3 = bfhi(xw[1]) + t[3] * rt * gg[3];
            float ss = x0 * x0 + x1 * x1 + x2 * x2 + x3 * x3;
            u32x2 w; w[0] = cvt_pk_bf16(x0, x1); w[1] = cvt_pk_bf16(x2, x3); *(u32x2*)xp = w;
            ss += __shfl_xor(ss, 16); ss += __shfl_xor(ss, 32); if (fq == 0) atomicAdd(rsn + row, (u64)(ss * FXS)); }
    }
};

__device__ __forceinline__ int seq_base(int s) { return s < 8 ? s * 2048 : NPR + (s - 8) * 8; }
__device__ __forceinline__ int seq_len(int s) { return s < 8 ? 2048 : 8; }

template <int LD_SRC, int K, int N, int LD_DST, int ROW_BLK, int ROW_BLK_STRIDE, int ROW_OFF, int NL, int START>
__device__ __forceinline__ void transpose_kind(const float* src0, bf16_t* dst0, size_t dst_stride, float* tile, const float* scale0 = nullptr, int sc_mul = 0, int sc_add = 0) {
    constexpr int NTN = (N + 63) / 64, PER = (K / 64) * NTN, TOT = PER * NL;
    const int tid = tid_opaque(), G = gridDim.x;
    const int first = ((bid_opaque() - START) % G + G) % G;
    f32x4 v[2];
#define TK_FETCH(tt) do { const int l_ = (tt) / PER, lt_ = (tt) % PER, k0_ = (lt_ / NTN) * 64, n0_ = (lt_ % NTN) * 64; const float* src_ = src0 + (size_t)l_ * K * LD_SRC; \
        _Pragma("unroll") for (int i = 0; i < 2; ++i) { const int idx = tid + i * 512, r = idx >> 4, c4 = (idx & 15) * 4; v[i] = (f32x4){0.f, 0.f, 0.f, 0.f}; \
            if (n0_ + c4 < N) v[i] = *(const f32x4*)(src_ + (size_t)(k0_ + r) * LD_SRC + n0_ + c4); } } while (0)
    if (first < TOT) TK_FETCH(first);
    for (int t = first; t < TOT; t += G) {
        const int l = t / PER, lt = t % PER, kt = lt / NTN, ntile = lt % NTN, k0 = kt * 64, n0 = ntile * 64;
        bf16_t* dst = dst0 + (size_t)l * dst_stride;
        LDSBAR();
#pragma unroll
        for (int i = 0; i < 2; ++i) { const int idx = tid + i * 512, r = idx >> 4, c4 = (idx & 15) * 4;
            tile[r * 65 + c4] = v[i][0]; tile[r * 65 + c4 + 1] = v[i][1]; tile[r * 65 + c4 + 2] = v[i][2]; tile[r * 65 + c4 + 3] = v[i][3]; }
        LDSBAR();
        if (t + G < TOT) TK_FETCH(t + G);
#pragma unroll
        for (int i = 0; i < 4; ++i) { const int idx = tid + i * 512, r = idx >> 5, c2 = (idx & 31) * 2, n = n0 + r;
            if (n < N) { const int drow = (n / ROW_BLK) * ROW_BLK_STRIDE + (n % ROW_BLK) + ROW_OFF;
                float sa = 1.f, sb = 1.f; if (scale0) { const float* sc = scale0 + (size_t)(l * sc_mul + sc_add) * 1024 + k0 + c2; sa = sc[0]; sb = sc[1]; }
                *(unsigned*)(dst + (size_t)drow * LD_DST + k0 + c2) = cvt_pk_bf16(tile[c2 * 65 + r] * sa, tile[(c2 + 1) * 65 + r] * sb); } }
    }
#undef TK_FETCH
    LDSBAR();
}
__device__ void phase_init(KParams& p, unsigned char* shm) {
    const int tid = tid_opaque(), G = gridDim.x, bid = bid_opaque();
    float* tile = (float*)shm;
    {
        bf16_t* Wt = (bf16_t*)(p.ws + WS_W);
        constexpr int T0 = 0, T1 = T0 + 2 * 16 * 48, T2 = T1 + 2 * 16 * 16, T3 = T2 + 2 * 16 * 81, T4 = T3 + 2 * 32 * 16, T5 = T4 + 4 * 16 * 44, T6 = T5 + 4 * 16 * 44, T7 = T6 + 4 * 44 * 16, T8 = T7 + 4 * 16 * 16;
        transpose_kind<3072, 1024, 3072, 1024, 3072, 3072, 0, 2, T0>(p.in[I_WEIN], Wt + WO_EIN, 3072ull * 1024, tile, p.in[I_GMIX], 2, 0);
        transpose_kind<1024, 1024, 1024, 1024, 1024, 1024, 0, 2, T1>(p.in[I_WEOUT], Wt + WO_EOUT, 1024ull * 1024, tile);
        transpose_kind<5152, 1024, 5152, 1024, 5152, 5152, 0, 2, T2>(p.in[I_SIN], Wt + WO_SIN, 5376ull * 1024, tile, p.in[I_GMIX], 2, 1);
        transpose_kind<1024, 2048, 1024, 2048, 1024, 1024, 0, 2, T3>(p.in[I_SOUT], Wt + WO_SOUT, 1024ull * 2048, tile, p.in[I_SGN], 2, 0);
        transpose_kind<2816, 1024, 2816, 1024, 128, 256, 0, 4, T4>(p.in[I_W1], Wt + WO_13, 5632ull * 1024, tile, p.in[I_GFFN], 1, 0);
        transpose_kind<2816, 1024, 2816, 1024, 128, 256, 128, 4, T5>(p.in[I_W3], Wt + WO_13, 5632ull * 1024, tile, p.in[I_GFFN], 1, 0);
        transpose_kind<1024, 2816, 1024, 2816, 1024, 1024, 0, 4, T6>(p.in[I_W2], Wt + WO_2, 1024ull * 2816, tile);
        transpose_kind<1024, 1024, 1024, 1024, 1024, 1024, 0, 4, T7>(p.in[I_PGATE], Wt + WO_G, 1024ull * 1024, tile);
        transpose_kind<1024, 256, 1024, 256, 1024, 1024, 0, 4, T8>(p.in[I_PUP], Wt + WO_U, 1024ull * 256, tile);
    }
    bf16_t* W = (bf16_t*)(p.ws + WS_W);
    for (int idx0 = bid * 512 + tid; idx0 < 2 * 1024 * 512; idx0 += 4 * G * 512) { float vv[4];
#pragma unroll
        for (int q = 0; q < 4; ++q) { const int idx = idx0 + q * G * 512; vv[q] = 0.f;
            if (idx < 2 * 1024 * 512) { const int k = idx & 511, n = (idx >> 9) & 1023, j = idx >> 19, hb = n >> 8, gate = (n >> 7) & 1, c = n & 127;
                if ((k >> 7) == hb) { const float* gw = gate ? p.in[I_LWX] : p.in[I_LWA]; vv[q] = gw[(((size_t)j * 4 + hb) * 128 + (k & 127)) * 128 + c]; } } }
#pragma unroll
        for (int q = 0; q < 4; ++q) { const int idx = idx0 + q * G * 512; if (idx < 2 * 1024 * 512) W[WO_LRU + idx] = f2bf(vv[q]); }
    }
    u64* RSN0 = (u64*)(p.ws + WS_RSS) + RSSN_OFF; bf16_t* XH = (bf16_t*)(p.ws + WS_XN);
    const int wid = tid >> 6, lane = tid & 63;
    for (int row0 = bid * 8 + wid; row0 < NTOK; row0 += 2 * G * 8) { f32x4 xv[2][4];
#pragma unroll
        for (int k = 0; k < 2; ++k) { const int row = row0 + k * G * 8;
#pragma unroll
            for (int i = 0; i < 4; ++i) xv[k][i] = (f32x4){0.f, 0.f, 0.f, 0.f};
            if (row < NTOK) { const float* src = row < NPR ? p.in[I_XP] + (size_t)row * 1024 : p.in[I_XS] + (size_t)(row - NPR) * 1024;
#pragma unroll
                for (int i = 0; i < 4; ++i) xv[k][i] = *(const f32x4*)(src + i * 256 + lane * 4); } }
#pragma unroll
        for (int k = 0; k < 2; ++k) { const int row = row0 + k * G * 8;
            if (row < NTOK) { float ss = 0.f;
#pragma unroll
                for (int i = 0; i < 4; ++i) { const int c = i * 256 + lane * 4; const f32x4 v = xv[k][i]; ss += v[0] * v[0] + v[1] * v[1] + v[2] * v[2] + v[3] * v[3];
                    u32x2 w; w[0] = cvt_pk_bf16(v[0], v[1]); w[1] = cvt_pk_bf16(v[2], v[3]); *(u32x2*)(XH + (size_t)row * 1024 + c) = w; }
                ss = wave_sum(ss); if (lane == 0) RSN0[row] = (u64)(ss * FXS); } }
    }
    bf16_t* PB = (bf16_t*)(p.ws + WS_PB);
    { const size_t total = 4ull * NTOK * 64, stride = (size_t)G * 512;
      for (size_t idx0 = (size_t)bid * 512 + tid; idx0 < total; idx0 += 4 * stride) { f32x4 v[4];
#pragma unroll
        for (int k = 0; k < 4; ++k) { const size_t idx = idx0 + k * stride; v[k] = (f32x4){0.f, 0.f, 0.f, 0.f};
            if (idx < total) { const int c4 = (int)(idx & 63); const size_t rt = idx >> 6; const int tok = (int)(rt % NTOK), l = (int)(rt / NTOK);
                const float* src = tok < NPR ? p.in[I_PP] + ((size_t)l * NPR + tok) * 256 : p.in[I_PS] + ((size_t)l * 1024 + (tok - NPR)) * 256;
                v[k] = *(const f32x4*)(src + c4 * 4); } }
#pragma unroll
        for (int k = 0; k < 4; ++k) { const size_t idx = idx0 + k * stride;
            if (idx < total) { u32x2 w; w[0] = cvt_pk_bf16(v[k][0], v[k][1]); w[1] = cvt_pk_bf16(v[k][2], v[k][3]); *(u32x2*)(PB + (idx >> 6) * 256 + (idx & 63) * 4) = w; } } } }
    u64* RSS = (u64*)(p.ws + WS_RSS);
    for (size_t idx = (size_t)bid * 512 + tid; idx < RSS_FLOATS; idx += (size_t)G * 512) if (idx < RSSN_OFF || idx >= RSSN_OFF + NTOK) RSS[idx] = 0ull;
}

__device__ void phase_conv_lru(KParams& p, int j) {
    const bf16_t* PROJ = (const bf16_t*)(p.ws + WS_PROJ); bf16_t* U = (bf16_t*)(p.ws + WS_U);
    const float* cw = p.in[I_LCW] + (size_t)j * 4 * 512; const float* cb = p.in[I_LCB] + (size_t)j * 512;
    for (int idx = bid_opaque() * 512 + tid_opaque(); idx < NTOK * 64; idx += gridDim.x * 512) {
        const int row = idx >> 6, c8 = (idx & 63) * 8;
        int t, L, b; const bool pr = row < NPR;
        if (pr) { t = row & 2047; L = 2048; b = row >> 11; } else { t = (row - NPR) & 7; L = 8; b = (row - NPR) >> 3; }
        float o[8];
#pragma unroll
        for (int q = 0; q < 8; ++q) o[q] = cb[c8 + q];
        float last[8];
#pragma unroll
        for (int k = 0; k < 4; ++k) { const int m = t + k; float v[8];
            if (m >= 3) { const u32x4 w = *(const u32x4*)(PROJ + (size_t)(row + k - 3) * 3072 + 2560 + c8);
#pragma unroll
                for (int q = 0; q < 4; ++q) { v[2 * q] = bflo(w[q]); v[2 * q + 1] = bfhi(w[q]); } }
            else if (!pr) { const float* sp = p.in[I_SLC] + (((size_t)j * 128 + b) * 3 + m) * 512 + c8;
#pragma unroll
                for (int q = 0; q < 8; ++q) v[q] = sp[q]; }
            else {
#pragma unroll
                for (int q = 0; q < 8; ++q) v[q] = 0.f; }
#pragma unroll
            for (int q = 0; q < 8; ++q) { o[q] += cw[k * 512 + c8 + q] * v[q]; if (k == 3) last[q] = v[q]; } }
        u32x4 w;
#pragma unroll
        for (int q = 0; q < 4; ++q) w[q] = cvt_pk_bf16(o[2 * q], o[2 * q + 1]);
        *(u32x4*)(U + (size_t)row * 512 + c8) = w;
        if (t >= L - 3) { const int r = t - (L - 3);
            float* dst = pr ? p.out + OO_LCP + (((size_t)j * 8 + b) * 3 + r) * 512 + c8 : p.out + OO_LCS + (((size_t)j * 128 + b) * 3 + r) * 512 + c8;
#pragma unroll
            for (int q = 0; q < 8; ++q) dst[q] = last[q]; }
    }
}

__device__ void hgrn_unit(KParams& p, int j, int s, int h, unsigned char* shm) {
    const int tid = tid_opaque(), dv = tid & 127, dq = tid >> 7, wid = tid >> 6, lane = tid & 63;
    const bf16_t* PROJ = (const bf16_t*)(p.ws + WS_PROJ); bf16_t* O = (bf16_t*)(p.ws + WS_O);
    float* qs = (float*)shm; float* fs = qs + 16 * 128; float* ks = fs + 16 * 128; float* vs = ks + 16 * 128; float* op = vs + 16 * 128;
    const int base = seq_base(s), L = seq_len(s), nb = L < 16 ? L : 16;
    float S[32];
    if (s >= 8) { const float* s0 = p.in[I_SHG] + (((size_t)j * 128 + (s - 8)) * 4 + h) * 16384;
#pragma unroll
        for (int i = 0; i < 32; ++i) S[i] = s0[(dq * 32 + i) * 128 + dv]; }
    else {
#pragma unroll
        for (int i = 0; i < 32; ++i) S[i] = 0.f; }
    const float gn0 = p.in[I_HGN][j * 512 + h * 128 + lane], gn1 = p.in[I_HGN][j * 512 + h * 128 + lane + 64];
    for (int t0 = 0; t0 < L; t0 += nb) {
        LDSBAR();
        for (int idx = tid; idx < nb * 128; idx += 512) { const int t = idx >> 7, dk = idx & 127; const size_t ro = (size_t)(base + t0 + t) * 3072 + h * 128 + dk;
            const float q = bf2f(PROJ[ro]), fz = bf2f(PROJ[ro + 512]);
            float lb = 0.f;
            if (j == 1) lb = sigmoidf_(p.in[I_HLB][512 + h * 128 + dk] - p.in[I_HLB][h * 128 + dk]);
            const float sg = sigmoidf_(fz);
            qs[idx] = siluf_(q); fs[idx] = lb + (1.f - lb) * sg; ks[idx] = (1.f - lb) * (1.f - sg); vs[idx] = bf2f(PROJ[ro + 1024]); }
        LDSBAR();
#pragma unroll 2
        for (int t = 0; t < nb; ++t) { float o = 0.f; const float vt = vs[t * 128 + dv];
#pragma unroll
            for (int i4 = 0; i4 < 8; ++i4) { const f32x4 f4 = *(const f32x4*)(fs + t * 128 + dq * 32 + i4 * 4), k4 = *(const f32x4*)(ks + t * 128 + dq * 32 + i4 * 4), q4 = *(const f32x4*)(qs + t * 128 + dq * 32 + i4 * 4);
#pragma unroll
                for (int e = 0; e < 4; ++e) { const int i = i4 * 4 + e; S[i] = f4[e] * S[i] + k4[e] * vt; o += q4[e] * S[i]; } }
            op[(t * 4 + dq) * 128 + dv] = o; }
        LDSBAR();
        for (int t = wid; t < nb; t += 8) { const int row = base + t0 + t;
            const float o0 = op[(t * 4 + 0) * 128 + lane] + op[(t * 4 + 1) * 128 + lane] + op[(t * 4 + 2) * 128 + lane] + op[(t * 4 + 3) * 128 + lane];
            const float o1 = op[(t * 4 + 0) * 128 + lane + 64] + op[(t * 4 + 1) * 128 + lane + 64] + op[(t * 4 + 2) * 128 + lane + 64] + op[(t * 4 + 3) * 128 + lane + 64];
            const float ss = wave_sum(o0 * o0 + o1 * o1), r = rsqrtf(ss * (1.f / 128.f) + EPSN);
            const float g0 = bf2f(PROJ[(size_t)row * 3072 + 1536 + h * 128 + lane]), g1 = bf2f(PROJ[(size_t)row * 3072 + 1536 + h * 128 + lane + 64]);
            O[(size_t)row * 1024 + h * 128 + lane] = f2bf(o0 * r * gn0 * siluf_(g0)); O[(size_t)row * 1024 + h * 128 + lane + 64] = f2bf(o1 * r * gn1 * siluf_(g1)); }
    }
    float* so = s < 8 ? p.out + OO_HGP + (((size_t)j * 8 + s) * 4 + h) * 16384 : p.out + OO_HGS + (((size_t)j * 128 + (s - 8)) * 4 + h) * 16384;
#pragma unroll
    for (int i = 0; i < 32; ++i) so[(dq * 32 + i) * 128 + dv] = S[i];
}


__device__ __forceinline__ f32x4 mfma16(bf16x8 a, bf16x8 b, f32x4 c) { return __builtin_amdgcn_mfma_f32_16x16x32_bf16(a, b, c, 0, 0, 0); }
__device__ void hgrn_prep_unit(KParams& p, int j, int u, unsigned char* shm) {
    const int tid = tid_opaque(), dk = tid & 127, seg = tid >> 7, lane = tid & 63, wid = tid >> 6, fr = lane & 15, fq = lane >> 4;
    const int c = u & 31, h = (u >> 5) & 3, b = u >> 7;
    const bf16_t* PROJ = (const bf16_t*)(p.ws + WS_PROJ);
    unsigned char* hp = p.ws + WS_HP + (size_t)u * HP_UNIT;
    bf16_t* gqe = (bf16_t*)hp; bf16_t* gpp = gqe + 8192; bf16_t* gkdt = gpp + 8192; bf16_t* gvt = gkdt + 8192; float* gbr = (float*)(hp + 65536); float* gbt = gbr + 128;
    bf16_t* lqe = (bf16_t*)shm; bf16_t* lke = (bf16_t*)(shm + 17408); float* segs = (float*)(shm + 40960);
    float lbv = 0.f;
    if (j == 1) lbv = sigmoidf_(p.in[I_HLB][512 + h * 128 + dk] - p.in[I_HLB][h * 128 + dk]);
    const size_t r0 = (size_t)b * 2048 + c * 64;
    float qq[16], kk[16], bl[16]; float run = 0.f;
#pragma unroll
    for (int i = 0; i < 16; ++i) { const size_t ro = (r0 + seg * 16 + i) * 3072 + h * 128 + dk;
        const float q = bf2f(PROJ[ro]), fz = bf2f(PROJ[ro + 512]); const float sg = sigmoidf_(fz);
        const float f = lbv + (1.f - lbv) * sg; kk[i] = (1.f - lbv) * (1.f - sg); qq[i] = siluf_(q); run += __logf(f); bl[i] = run; }
    unsigned vw[8];
#pragma unroll
    for (int i = 0; i < 8; ++i) { const size_t ro = (r0 + seg * 16 + 2 * i) * 3072 + 1024 + h * 128 + dk; vw[i] = (unsigned)PROJ[ro] | ((unsigned)PROJ[ro + 3072] << 16); }
    __syncthreads();
    segs[seg * 128 + dk] = run;
    __syncthreads();
    const float s0 = segs[dk], s1 = segs[128 + dk], s2 = segs[256 + dk], s3 = segs[384 + dk];
    const float bref = s0 + s1, tot = bref + s2 + s3, off = seg == 0 ? 0.f : (seg == 1 ? s0 : (seg == 2 ? bref : bref + s2));
    unsigned kdw[8];
#pragma unroll
    for (int i = 0; i < 16; ++i) { const float bb = off + bl[i]; const int t = seg * 16 + i;
        const bf16_t qv = f2bf(qq[i] * __expf(bb - bref)); gqe[t * 128 + dk] = qv; lqe[t * 136 + dk] = qv; lke[t * 136 + dk] = f2bf(kk[i] * __expf(bref - bb));
        const unsigned kd = f2bf(kk[i] * __expf(tot - bb)); if (i & 1) kdw[i >> 1] |= kd << 16; else kdw[i >> 1] = kd; }
    u32x4 w0, w1; w0[0] = kdw[0]; w0[1] = kdw[1]; w0[2] = kdw[2]; w0[3] = kdw[3]; w1[0] = kdw[4]; w1[1] = kdw[5]; w1[2] = kdw[6]; w1[3] = kdw[7];
    *(u32x4*)(gkdt + dk * 64 + seg * 16) = w0; *(u32x4*)(gkdt + dk * 64 + seg * 16 + 8) = w1;
    w0[0] = vw[0]; w0[1] = vw[1]; w0[2] = vw[2]; w0[3] = vw[3]; w1[0] = vw[4]; w1[1] = vw[5]; w1[2] = vw[6]; w1[3] = vw[7];
    *(u32x4*)(gvt + dk * 64 + seg * 16) = w0; *(u32x4*)(gvt + dk * 64 + seg * 16 + 8) = w1;
    if (seg == 0) { gbr[dk] = bref; gbt[dk] = tot; }
    __syncthreads();
    {
        const int ti = wid >> 1, si0 = (wid & 1) * 2;
#pragma unroll
        for (int q = 0; q < 2; ++q) { const int si = si0 + q; f32x4 a = (f32x4){0.f, 0.f, 0.f, 0.f};
            if (si <= ti) {
#pragma unroll
                for (int k4 = 0; k4 < 4; ++k4) a = mfma16(*(const bf16x8*)(lqe + (ti * 16 + fr) * 136 + k4 * 32 + fq * 8), *(const bf16x8*)(lke + (si * 16 + fr) * 136 + k4 * 32 + fq * 8), a); }
#pragma unroll
            for (int jj = 0; jj < 4; ++jj) { const int t = ti * 16 + fq * 4 + jj, sx = si * 16 + fr; gpp[t * 64 + sx] = f2bf(sx <= t ? a[jj] : 0.f); } }
    }
}
__device__ void hgrn_prompt_unit(KParams& p, int j, int b, int h, unsigned char* shm) {
    const int tid = tid_opaque(), lane = tid & 63, wid = tid >> 6, fr = lane & 15, fq = lane >> 4;
    const bf16_t* PROJ = (const bf16_t*)(p.ws + WS_PROJ); bf16_t* O = (bf16_t*)(p.ws + WS_O);
    constexpr int QE = 0, KE = 17408, KDT = 34816, VT = 53248, PP = 71680, STS = 80896;
    bf16_t* qe = (bf16_t*)(shm + QE); bf16_t* ke = (bf16_t*)(shm + KE); bf16_t* kdt = (bf16_t*)(shm + KDT); bf16_t* vt = (bf16_t*)(shm + VT);
    bf16_t* pp = (bf16_t*)(shm + PP); bf16_t* sts = (bf16_t*)(shm + STS); float* ob = (float*)(shm + KDT);
    const unsigned char* hp0 = p.ws + WS_HP + (size_t)((b * 4 + h) * 32) * HP_UNIT;
    f32x4 Sacc[8];
#pragma unroll
    for (int i = 0; i < 8; ++i) Sacc[i] = (f32x4){0.f, 0.f, 0.f, 0.f};
    u32x4 rq[2], rp, rd[2], rv[2]; float brv[8], btv[8];
#define HG_FETCH(cc) do { const unsigned char* hp = hp0 + (size_t)(cc) * HP_UNIT; \
        _Pragma("unroll") for (int q = 0; q < 2; ++q) { const int ch = tid + q * 512; rq[q] = *(const u32x4*)(hp + ch * 16); rd[q] = *(const u32x4*)(hp + 32768 + ch * 16); rv[q] = *(const u32x4*)(hp + 49152 + ch * 16); } \
        rp = *(const u32x4*)(hp + 16384 + tid * 16); \
        _Pragma("unroll") for (int td = 0; td < 8; ++td) { brv[td] = ((const float*)(hp + 65536))[td * 16 + fr]; btv[td] = ((const float*)(hp + 65536))[128 + td * 16 + fr]; } } while (0)
    float gnv[16];
    { const float* gn = p.in[I_HGN] + j * 512 + h * 128 + (tid & 7) * 16;
#pragma unroll
      for (int q = 0; q < 16; ++q) gnv[q] = gn[q]; }
    HG_FETCH(0);
    for (int c = 0; c < 32; ++c) {
        const size_t r0 = (size_t)b * 2048 + c * 64;
        LDSBAR();
        float dec[8];
#pragma unroll
        for (int q = 0; q < 2; ++q) { const int ch = tid + q * 512;
            *(u32x4*)(qe + (ch >> 4) * 136 + (ch & 15) * 8) = rq[q];
            *(u32x4*)(kdt + (ch >> 3) * 72 + (ch & 7) * 8) = rd[q]; *(u32x4*)(vt + (ch >> 3) * 72 + (ch & 7) * 8) = rv[q]; }
        *(u32x4*)(pp + (tid >> 3) * 72 + (tid & 7) * 8) = rp;
#pragma unroll
        for (int td = 0; td < 8; ++td) { const float sc = __expf(brv[td]); dec[td] = __expf(btv[td]);
#pragma unroll
            for (int jj = 0; jj < 4; ++jj) sts[(wid * 16 + fq * 4 + jj) * 136 + td * 16 + fr] = f2bf(Sacc[td][jj] * sc); }
        if (c + 1 < 32) HG_FETCH(c + 1);
        const int et = tid >> 3, part = tid & 7; const size_t erow = r0 + et;
        const u32x4 g0 = *(const u32x4*)(PROJ + erow * 3072 + 1536 + h * 128 + part * 16), g1 = *(const u32x4*)(PROJ + erow * 3072 + 1536 + h * 128 + part * 16 + 8);
        LDSBAR();
        f32x4 oacc[4];
        {
            const int ti = wid & 3, dv0 = (wid >> 2) * 4;
#pragma unroll
            for (int d = 0; d < 4; ++d) oacc[d] = (f32x4){0.f, 0.f, 0.f, 0.f};
#pragma unroll
            for (int k4 = 0; k4 < 4; ++k4) { const bf16x8 a = *(const bf16x8*)(qe + (ti * 16 + fr) * 136 + k4 * 32 + fq * 8);
#pragma unroll
                for (int d = 0; d < 4; ++d) oacc[d] = mfma16(a, *(const bf16x8*)(sts + ((dv0 + d) * 16 + fr) * 136 + k4 * 32 + fq * 8), oacc[d]); }
#pragma unroll
            for (int k2 = 0; k2 < 2; ++k2) { const bf16x8 a = *(const bf16x8*)(pp + (ti * 16 + fr) * 72 + k2 * 32 + fq * 8);
#pragma unroll
                for (int d = 0; d < 4; ++d) oacc[d] = mfma16(a, *(const bf16x8*)(vt + ((dv0 + d) * 16 + fr) * 72 + k2 * 32 + fq * 8), oacc[d]); }
            const bf16x8 v0 = *(const bf16x8*)(vt + (wid * 16 + fr) * 72 + fq * 8), v1 = *(const bf16x8*)(vt + (wid * 16 + fr) * 72 + 32 + fq * 8);
#pragma unroll
            for (int td = 0; td < 8; ++td) { Sacc[td] = Sacc[td] * dec[td];
                Sacc[td] = mfma16(v0, *(const bf16x8*)(kdt + (td * 16 + fr) * 72 + fq * 8), Sacc[td]);
                Sacc[td] = mfma16(v1, *(const bf16x8*)(kdt + (td * 16 + fr) * 72 + 32 + fq * 8), Sacc[td]); }
        }
        LDSBAR();
        {
            const int ti = wid & 3, dv0 = (wid >> 2) * 4;
#pragma unroll
            for (int d = 0; d < 4; ++d)
#pragma unroll
                for (int jj = 0; jj < 4; ++jj) ob[(ti * 16 + fq * 4 + jj) * 132 + (dv0 + d) * 16 + fr] = oacc[d][jj];
        }
        LDSBAR();
        {
            float o[16]; float ss = 0.f;
#pragma unroll
            for (int q4 = 0; q4 < 4; ++q4) { const f32x4 v = *(const f32x4*)(ob + et * 132 + part * 16 + q4 * 4); o[q4 * 4] = v[0]; o[q4 * 4 + 1] = v[1]; o[q4 * 4 + 2] = v[2]; o[q4 * 4 + 3] = v[3];
                ss += v[0] * v[0] + v[1] * v[1] + v[2] * v[2] + v[3] * v[3]; }
            ss += __shfl_xor(ss, 1); ss += __shfl_xor(ss, 2); ss += __shfl_xor(ss, 4);
            const float r = rsqrtf(ss * (1.f / 128.f) + EPSN);
            u32x4 w0, w1;
#pragma unroll
            for (int q = 0; q < 4; ++q) {
                w0[q] = cvt_pk_bf16(o[2 * q] * r * gnv[2 * q] * siluf_(bflo(g0[q])), o[2 * q + 1] * r * gnv[2 * q + 1] * siluf_(bfhi(g0[q])));
                w1[q] = cvt_pk_bf16(o[8 + 2 * q] * r * gnv[8 + 2 * q] * siluf_(bflo(g1[q])), o[8 + 2 * q + 1] * r * gnv[8 + 2 * q + 1] * siluf_(bfhi(g1[q]))); }
            *(u32x4*)(O + erow * 1024 + h * 128 + part * 16) = w0; *(u32x4*)(O + erow * 1024 + h * 128 + part * 16 + 8) = w1;
        }
    }
#undef HG_FETCH
    float* so = p.out + OO_HGP + (((size_t)j * 8 + b) * 4 + h) * 16384;
#pragma unroll
    for (int td = 0; td < 8; ++td) *(f32x4*)(so + (size_t)(td * 16 + fr) * 128 + wid * 16 + fq * 4) = Sacc[td];
    LDSBAR();
}

__device__ void lru_scan_prompt(KParams& p, int j, int b, int cg16, unsigned char* shm) {
    const int tid = tid_opaque(), cl = tid & 15, ch = cg16 * 16 + cl, seg = tid >> 4;
    const float* LA = (const float*)(p.ws + WS_ON); const float* LBT = LA + (size_t)NTOK * 512;
    const bf16_t* PROJ = (const bf16_t*)(p.ws + WS_PROJ); bf16_t* O = (bf16_t*)(p.ws + WS_O);
    float* sA = (float*)shm; float* sH = sA + 512;
    const size_t r0 = (size_t)b * 2048 + seg * 64;
    float A = 1.f, H = 0.f;
    for (int t0 = 0; t0 < 64; t0 += 16) { float av[16], bv[16];
#pragma unroll
        for (int t = 0; t < 16; ++t) { av[t] = LA[(r0 + t0 + t) * 512 + ch]; bv[t] = LBT[(r0 + t0 + t) * 512 + ch]; }
#pragma unroll
        for (int t = 0; t < 16; ++t) { H = av[t] * H + bv[t]; A *= av[t]; } }
    __syncthreads();
    sA[tid] = A; sH[tid] = H;
    __syncthreads();
    float hc = 0.f;
    for (int s2 = 0; s2 < seg; ++s2) hc = sA[s2 * 16 + cl] * hc + sH[s2 * 16 + cl];
    for (int t0 = 0; t0 < 64; t0 += 16) { float av[16], bv[16], yv[16];
#pragma unroll
        for (int t = 0; t < 16; ++t) { av[t] = LA[(r0 + t0 + t) * 512 + ch]; bv[t] = LBT[(r0 + t0 + t) * 512 + ch]; yv[t] = bf2f(PROJ[(r0 + t0 + t) * 3072 + 2048 + ch]); }
#pragma unroll
        for (int t = 0; t < 16; ++t) { hc = av[t] * hc + bv[t]; O[(r0 + t0 + t) * 1024 + 512 + ch] = f2bf(geluf_(yv[t]) * hc); } }
    if (seg == 31) p.out[OO_LHP + ((size_t)j * 8 + b) * 512 + ch] = hc;
}
__device__ void lru_scan_sample(KParams& p, int j, int b) {
    const int ch = tid_opaque();
    const float* LA = (const float*)(p.ws + WS_ON); const float* LBT = LA + (size_t)NTOK * 512;
    const bf16_t* PROJ = (const bf16_t*)(p.ws + WS_PROJ); bf16_t* O = (bf16_t*)(p.ws + WS_O);
    float hc = p.in[I_SLH][((size_t)j * 128 + b) * 512 + ch];
    const size_t r0 = NPR + (size_t)b * 8;
#pragma unroll
    for (int t = 0; t < 8; ++t) { const float a = LA[(r0 + t) * 512 + ch], bt = LBT[(r0 + t) * 512 + ch]; hc = a * hc + bt;
        const float yb = bf2f(PROJ[(r0 + t) * 3072 + 2048 + ch]);
        O[(r0 + t) * 1024 + 512 + ch] = f2bf(geluf_(yb) * hc); }
    p.out[OO_LHS + ((size_t)j * 128 + b) * 512 + ch] = hc;
}
__device__ void phase_even_scan(KParams& p, int j, unsigned char* shm) {
    const int bid = bid_opaque(), G = gridDim.x;
    for (int w = bid - 32; w < 896; w += G - 32) {
        if (w < 512) { const int v = w + 32; hgrn_unit(p, j, v >> 2, v & 3, shm); }
        else if (w < 768) lru_scan_prompt(p, j, (w - 512) >> 5, (w - 512) & 31, shm);
        else lru_scan_sample(p, j, w - 768);
    }
}

__device__ void phase_conv_ssm(KParams& p, int j) {
    const bf16_t* PROJ = (const bf16_t*)(p.ws + WS_PROJ); bf16_t* XBC = (bf16_t*)(p.ws + WS_U);
    const float* cw = p.in[I_SCW] + (size_t)j * 4 * 3072; const float* cb = p.in[I_SCB] + (size_t)j * 3072;
    for (int idx = bid_opaque() * 512 + tid_opaque(); idx < 512 * 384; idx += gridDim.x * 512) {
        const int rb = idx / 384, c8 = (idx % 384) * 8, r0 = rb * 32, t0 = r0 & 2047, b = r0 >> 11;
        float w[4][8], bias[8], h[3][8];
#pragma unroll
        for (int k = 0; k < 4; ++k) { const f32x4 a = *(const f32x4*)(cw + k * 3072 + c8), c = *(const f32x4*)(cw + k * 3072 + c8 + 4);
            w[k][0] = a[0]; w[k][1] = a[1]; w[k][2] = a[2]; w[k][3] = a[3]; w[k][4] = c[0]; w[k][5] = c[1]; w[k][6] = c[2]; w[k][7] = c[3]; }
        { const f32x4 a = *(const f32x4*)(cb + c8), c = *(const f32x4*)(cb + c8 + 4); bias[0] = a[0]; bias[1] = a[1]; bias[2] = a[2]; bias[3] = a[3]; bias[4] = c[0]; bias[5] = c[1]; bias[6] = c[2]; bias[7] = c[3]; }
#pragma unroll
        for (int k = 0; k < 3; ++k) { u32x4 hw = (u32x4){0u, 0u, 0u, 0u}; if (t0 != 0) hw = *(const u32x4*)(PROJ + (size_t)(r0 - 3 + k) * 5376 + 2048 + c8);
#pragma unroll
            for (int q = 0; q < 4; ++q) { h[k][2 * q] = bflo(hw[q]); h[k][2 * q + 1] = bfhi(hw[q]); } }
        for (int rr = 0; rr < 32; rr += 8) { u32x4 in[8];
#pragma unroll
            for (int e = 0; e < 8; ++e) in[e] = *(const u32x4*)(PROJ + (size_t)(r0 + rr + e) * 5376 + 2048 + c8);
#pragma unroll
            for (int e = 0; e < 8; ++e) { float cur[8]; u32x4 ow;
#pragma unroll
                for (int q = 0; q < 4; ++q) { cur[2 * q] = bflo(in[e][q]); cur[2 * q + 1] = bfhi(in[e][q]); }
#pragma unroll
                for (int q = 0; q < 4; ++q) { const float o0 = bias[2 * q] + w[0][2 * q] * h[0][2 * q] + w[1][2 * q] * h[1][2 * q] + w[2][2 * q] * h[2][2 * q] + w[3][2 * q] * cur[2 * q];
                    const float o1 = bias[2 * q + 1] + w[0][2 * q + 1] * h[0][2 * q + 1] + w[1][2 * q + 1] * h[1][2 * q + 1] + w[2][2 * q + 1] * h[2][2 * q + 1] + w[3][2 * q + 1] * cur[2 * q + 1];
                    ow[q] = cvt_pk_bf16(siluf_(o0), siluf_(o1)); }
                *(u32x4*)(XBC + (size_t)(r0 + rr + e) * 3072 + c8) = ow;
#pragma unroll
                for (int q = 0; q < 8; ++q) { h[0][q] = h[1][q]; h[1][q] = h[2][q]; h[2][q] = cur[q]; } } }
        if (t0 + 32 == 2048) { float* dst = p.out + OO_SCP + (((size_t)j * 8 + b) * 3) * 3072 + c8;
#pragma unroll
            for (int k = 0; k < 3; ++k)
#pragma unroll
                for (int q = 0; q < 8; ++q) dst[(size_t)k * 3072 + q] = h[k][q]; }
    }
    for (int idx = bid_opaque() * 512 + tid_opaque(); idx < 1024 * 384; idx += gridDim.x * 512) {
        const int row = NPR + idx / 384, c8 = (idx % 384) * 8;
        int t, L, b; const bool pr = row < NPR;
        if (pr) { t = row & 2047; L = 2048; b = row >> 11; } else { t = (row - NPR) & 7; L = 8; b = (row - NPR) >> 3; }
        float o[8], last[8];
#pragma unroll
        for (int q = 0; q < 8; ++q) o[q] = cb[c8 + q];
#pragma unroll
        for (int k = 0; k < 4; ++k) { const int m = t + k; float v[8];
            if (m >= 3) { const u32x4 w = *(const u32x4*)(PROJ + (size_t)(row + k - 3) * 5376 + 2048 + c8);
#pragma unroll
                for (int q = 0; q < 4; ++q) { v[2 * q] = bflo(w[q]); v[2 * q + 1] = bfhi(w[q]); } }
            else if (!pr) { const float* sp = p.in[I_SSC] + (((size_t)j * 128 + b) * 3 + m) * 3072 + c8;
#pragma unroll
                for (int q = 0; q < 8; ++q) v[q] = sp[q]; }
            else {
#pragma unroll
                for (int q = 0; q < 8; ++q) v[q] = 0.f; }
#pragma unroll
            for (int q = 0; q < 8; ++q) { o[q] += cw[k * 3072 + c8 + q] * v[q]; if (k == 3) last[q] = v[q]; } }
        u32x4 w;
#pragma unroll
        for (int q = 0; q < 4; ++q) w[q] = cvt_pk_bf16(siluf_(o[2 * q]), siluf_(o[2 * q + 1]));
        *(u32x4*)(XBC + (size_t)row * 3072 + c8) = w;
        if (t >= L - 3) { const int r = t - (L - 3);
            float* dst = pr ? p.out + OO_SCP + (((size_t)j * 8 + b) * 3 + r) * 3072 + c8 : p.out + OO_SCS + (((size_t)j * 128 + b) * 3 + r) * 3072 + c8;
#pragma unroll
            for (int q = 0; q < 8; ++q) dst[q] = last[q]; }
    }
    float* DT = (float*)(p.ws + WS_DT); float* DA = DT + (size_t)NTOK * 32;
    for (int idx = bid_opaque() * 512 + tid_opaque(); idx < NTOK * 32; idx += gridDim.x * 512) {
        const int row = idx >> 5, h = idx & 31;
        const float dt = softplusf_(bf2f(PROJ[(size_t)row * 5376 + 5120 + h]) + p.in[I_SDTB][j * 32 + h]);
        DT[idx] = dt; DA[idx] = __expf(-dt * __expf(p.in[I_SALOG][j * 32 + h]));
    }
}

__device__ void ssd_unit(KParams& p, int j, int s, int h, unsigned char* shm) {
    const int tid = tid_opaque(), pp = tid & 63, nq = tid >> 6, g = h >> 3;
    const bf16_t* PROJ = (const bf16_t*)(p.ws + WS_PROJ); const bf16_t* XBC = (const bf16_t*)(p.ws + WS_U); bf16_t* O = (bf16_t*)(p.ws + WS_O);
    const float* DT = (const float*)(p.ws + WS_DT); const float* DA = DT + (size_t)NTOK * 32;
    u64* GSS = (u64*)(p.ws + WS_RSS) + 8 * (size_t)NTOK + (size_t)j * NTOK * 4;
    float* Bs = (float*)shm; float* Cs = Bs + 16 * 128; float* xs = Cs + 16 * 128; float* dts = xs + 16 * 64; float* das = dts + 16; float* yp = das + 16;
    const int base = seq_base(s), L = seq_len(s), nb = L < 16 ? L : 16;
    const float Dh = p.in[I_SD][j * 32 + h];
    float S[16];
    if (s >= 8) { const float* s0 = p.in[I_SSM] + ((((size_t)j * 128 + (s - 8)) * 32 + h) * 64 + pp) * 128 + nq * 16;
#pragma unroll
        for (int i4 = 0; i4 < 4; ++i4) { const f32x4 v = *(const f32x4*)(s0 + i4 * 4); S[i4 * 4] = v[0]; S[i4 * 4 + 1] = v[1]; S[i4 * 4 + 2] = v[2]; S[i4 * 4 + 3] = v[3]; } }
    else {
#pragma unroll
        for (int i = 0; i < 16; ++i) S[i] = 0.f; }
    for (int t0 = 0; t0 < L; t0 += nb) {
        __syncthreads();
        for (int idx = tid; idx < nb * 128; idx += 512) { const int t = idx >> 7, n = idx & 127; const size_t ro = (size_t)(base + t0 + t) * 3072;
            Bs[idx] = bf2f(XBC[ro + 2048 + g * 128 + n]); Cs[idx] = bf2f(XBC[ro + 2560 + g * 128 + n]); }
        for (int idx = tid; idx < nb * 64; idx += 512) { const int t = idx >> 6, q = idx & 63; xs[idx] = bf2f(XBC[(size_t)(base + t0 + t) * 3072 + h * 64 + q]); }
        if (tid < nb) { dts[tid] = DT[(size_t)(base + t0 + tid) * 32 + h]; das[tid] = DA[(size_t)(base + t0 + tid) * 32 + h]; }
        __syncthreads();
#pragma unroll 2
        for (int t = 0; t < nb; ++t) { { const float xdt = xs[t * 64 + pp] * dts[t], da = das[t]; float y = 0.f;
#pragma unroll
                for (int i4 = 0; i4 < 4; ++i4) { const f32x4 b4 = *(const f32x4*)(Bs + t * 128 + nq * 16 + i4 * 4), c4 = *(const f32x4*)(Cs + t * 128 + nq * 16 + i4 * 4);
#pragma unroll
                    for (int e = 0; e < 4; ++e) { const int i = i4 * 4 + e; S[i] = da * S[i] + xdt * b4[e]; y += c4[e] * S[i]; } }
                yp[(t * 8 + nq) * 64 + pp] = y; } }
        __syncthreads();
        for (int t = nq; t < nb; t += 8) { const int row = base + t0 + t; float y = Dh * xs[t * 64 + pp];
#pragma unroll
            for (int q = 0; q < 8; ++q) y += yp[(t * 8 + q) * 64 + pp];
            const float z = bf2f(PROJ[(size_t)row * 5376 + h * 64 + pp]);
            y *= siluf_(z);
            O[(size_t)row * 2048 + h * 64 + pp] = f2bf(y);
            const float ss = wave_sum(y * y);
            if (pp == 0) atomicAdd(GSS + (size_t)g * NTOK + row, (u64)(ss * FXS)); }
    }
    float* so = s < 8 ? p.out + OO_SSP + ((((size_t)j * 8 + s) * 32 + h) * 64 + pp) * 128 + nq * 16 : p.out + OO_SSS + ((((size_t)j * 128 + (s - 8)) * 32 + h) * 64 + pp) * 128 + nq * 16;
#pragma unroll
    for (int i4 = 0; i4 < 4; ++i4) { f32x4 v; v[0] = S[i4 * 4]; v[1] = S[i4 * 4 + 1]; v[2] = S[i4 * 4 + 2]; v[3] = S[i4 * 4 + 3]; *(f32x4*)(so + i4 * 4) = v; }
}

__device__ void ssd_prompt_unit(KParams& p, int j, int b, int h, unsigned char* shm) {
    const int tid = tid_opaque(), lane = tid & 63, wid = tid >> 6, fr = lane & 15, fq = lane >> 4, g = h >> 3;
    const bf16_t* PROJ = (const bf16_t*)(p.ws + WS_PROJ); const bf16_t* XBC = (const bf16_t*)(p.ws + WS_U); bf16_t* O = (bf16_t*)(p.ws + WS_O);
    const float* DT = (const float*)(p.ws + WS_DT);
    u64* GSS = (u64*)(p.ws + WS_RSS) + 8 * (size_t)NTOK + (size_t)j * NTOK * 4;
    constexpr int CM = 0, BM = 17408, BMT = 34816, XT = 53248, XWT = 62464, PP = 71680, SB = 80896, CUM = 98304, DTS = 98560, GP = 98816;
    bf16_t* cm = (bf16_t*)(shm + CM); bf16_t* bm = (bf16_t*)(shm + BM); bf16_t* bmt = (bf16_t*)(shm + BMT); bf16_t* xt = (bf16_t*)(shm + XT); bf16_t* xwt = (bf16_t*)(shm + XWT);
    bf16_t* pp = (bf16_t*)(shm + PP); bf16_t* sb = (bf16_t*)(shm + SB); float* cum = (float*)(shm + CUM); float* dts = (float*)(shm + DTS); float* gpart = (float*)(shm + GP);
    const float Ah = -__expf(p.in[I_SALOG][j * 32 + h]), Dh = p.in[I_SD][j * 32 + h];
    const int pt = wid >> 1, nt0 = (wid & 1) * 4;
    f32x4 Sacc[4];
#pragma unroll
    for (int q = 0; q < 4; ++q) Sacc[q] = (f32x4){0.f, 0.f, 0.f, 0.f};
    u32x4 cw[2], bw[2], xw; float dtv = 0.f; bf16_t zv[8];
    const int xrow = tid >> 3, xc8 = tid & 7;
#define SSD_FETCH(cc) do { const size_t rn = (size_t)b * 2048 + (cc) * 64; \
        _Pragma("unroll") for (int q = 0; q < 2; ++q) { const int ch = tid + q * 512, row = ch >> 4, c16 = ch & 15; const size_t ro = (rn + row) * 3072 + g * 128 + c16 * 8; \
            bw[q] = *(const u32x4*)(XBC + ro + 2048); cw[q] = *(const u32x4*)(XBC + ro + 2560); } \
        xw = *(const u32x4*)(XBC + (rn + xrow) * 3072 + h * 64 + xc8 * 8); \
        if (wid == 0) dtv = DT[(rn + lane) * 32 + h]; \
        _Pragma("unroll") for (int q = 0; q < 2; ++q) _Pragma("unroll") for (int jj = 0; jj < 4; ++jj) \
            zv[q * 4 + jj] = PROJ[(rn + (wid >> 1) * 16 + fq * 4 + jj) * 5376 + h * 64 + ((wid & 1) * 2 + q) * 16 + fr]; } while (0)
    SSD_FETCH(0);
    for (int c = 0; c < 32; ++c) {
        const size_t r0 = (size_t)b * 2048 + c * 64;
        if (c > 0 && wid == 0) atomicAdd(GSS + (size_t)g * NTOK + (r0 - 64) + lane, (u64)((gpart[lane] + gpart[64 + lane]) * FXS));
        if (wid == 0) { const float dt = dtv; float la = dt * Ah;
#pragma unroll
            for (int o = 1; o < 64; o <<= 1) { const float t = __shfl_up(la, o); if (lane >= o) la += t; }
            cum[lane] = la; dts[lane] = dt; }
        bf16_t zc[8];
#pragma unroll
        for (int q = 0; q < 8; ++q) zc[q] = zv[q];
        LDSBAR();
        {
#pragma unroll
            for (int q = 0; q < 2; ++q) { const int ch = tid + q * 512, row = ch >> 4, c16 = ch & 15;
                *(u32x4*)(cm + row * 136 + c16 * 8) = cw[q]; *(u32x4*)(bm + row * 136 + c16 * 8) = bw[q];
#pragma unroll
                for (int e = 0; e < 4; ++e) { const int rs = row ^ ((c16 & 7) << 3); bmt[(c16 * 8 + 2 * e) * 72 + rs] = (bf16_t)(bw[q][e] & 0xffffu); bmt[(c16 * 8 + 2 * e + 1) * 72 + rs] = (bf16_t)(bw[q][e] >> 16); } }
            const float wsc = __expf(cum[63] - cum[xrow]) * dts[xrow];
#pragma unroll
            for (int e = 0; e < 4; ++e) { const bf16_t lo = (bf16_t)(xw[e] & 0xffffu), hi = (bf16_t)(xw[e] >> 16);
                const int xs_ = xrow ^ (xc8 << 3);
                xt[(xc8 * 8 + 2 * e) * 72 + xs_] = lo; xt[(xc8 * 8 + 2 * e + 1) * 72 + xs_] = hi;
                xwt[(xc8 * 8 + 2 * e) * 72 + xs_] = f2bf(bf2f(lo) * wsc); xwt[(xc8 * 8 + 2 * e + 1) * 72 + xs_] = f2bf(bf2f(hi) * wsc); }
#pragma unroll
            for (int q = 0; q < 4; ++q)
#pragma unroll
                for (int jj = 0; jj < 4; ++jj) sb[(pt * 16 + fq * 4 + jj) * 136 + (nt0 + q) * 16 + fr] = f2bf(Sacc[q][jj]);
        }
        if (c + 1 < 32) SSD_FETCH(c + 1);
        LDSBAR();
        {
            const int ti = wid >> 1, si0 = (wid & 1) * 2;
#pragma unroll
            for (int q = 0; q < 2; ++q) { const int si = si0 + q; f32x4 a = (f32x4){0.f, 0.f, 0.f, 0.f};
                if (si <= ti) {
#pragma unroll
                    for (int k4 = 0; k4 < 4; ++k4) a = mfma16(*(const bf16x8*)(cm + (ti * 16 + fr) * 136 + k4 * 32 + fq * 8), *(const bf16x8*)(bm + (si * 16 + fr) * 136 + k4 * 32 + fq * 8), a); }
                const int s2 = si * 16 + fr; const float cs = cum[s2], ds = dts[s2];
#pragma unroll
                for (int jj = 0; jj < 4; ++jj) { const int t = ti * 16 + fq * 4 + jj; const float v = a[jj] * __expf(cum[t] - cs) * ds; pp[t * 72 + s2] = f2bf(s2 <= t ? v : 0.f); } }
        }
        LDSBAR();
        {
            const int ti = wid >> 1, pi0 = (wid & 1) * 2;
            f32x4 oa[2];
#pragma unroll
            for (int q = 0; q < 2; ++q) oa[q] = (f32x4){0.f, 0.f, 0.f, 0.f};
#pragma unroll
            for (int k4 = 0; k4 < 4; ++k4) { const bf16x8 a = *(const bf16x8*)(cm + (ti * 16 + fr) * 136 + k4 * 32 + fq * 8);
#pragma unroll
                for (int q = 0; q < 2; ++q) oa[q] = mfma16(a, *(const bf16x8*)(sb + ((pi0 + q) * 16 + fr) * 136 + k4 * 32 + fq * 8), oa[q]); }
            float ec[4];
#pragma unroll
            for (int jj = 0; jj < 4; ++jj) ec[jj] = __expf(cum[ti * 16 + fq * 4 + jj]);
#pragma unroll
            for (int q = 0; q < 2; ++q)
#pragma unroll
                for (int jj = 0; jj < 4; ++jj) oa[q][jj] *= ec[jj];
#pragma unroll
            for (int k2 = 0; k2 < 2; ++k2) { const bf16x8 a = *(const bf16x8*)(pp + (ti * 16 + fr) * 72 + k2 * 32 + fq * 8);
#pragma unroll
                for (int q = 0; q < 2; ++q) oa[q] = mfma16(a, *(const bf16x8*)(xt + ((pi0 + q) * 16 + fr) * 72 + ((k2 * 32 + fq * 8) ^ (((((pi0 + q) * 16 + fr) >> 3) & 7) << 3))), oa[q]); }
            float ss[4] = {0.f, 0.f, 0.f, 0.f};
#pragma unroll
            for (int q = 0; q < 2; ++q)
#pragma unroll
                for (int jj = 0; jj < 4; ++jj) { const int t = ti * 16 + fq * 4 + jj, pc = (pi0 + q) * 16 + fr; const size_t row = r0 + t;
                    float y = oa[q][jj] + Dh * bf2f(xt[pc * 72 + (t ^ (((pc >> 3) & 7) << 3))]);
                    y *= siluf_(bf2f(zc[q * 4 + jj]));
                    O[row * 2048 + h * 64 + pc] = f2bf(y); ss[jj] += y * y; }
#pragma unroll
            for (int jj = 0; jj < 4; ++jj) { float v = ss[jj]; v += __shfl_xor(v, 1); v += __shfl_xor(v, 2); v += __shfl_xor(v, 4); v += __shfl_xor(v, 8);
                if (fr == 0) gpart[(wid & 1) * 64 + ti * 16 + fq * 4 + jj] = v; }
            const float dec = __expf(cum[63]);
            const int xsw = (((pt * 16 + fr) >> 3) & 7) << 3;
            const bf16x8 a0 = *(const bf16x8*)(xwt + (pt * 16 + fr) * 72 + ((fq * 8) ^ xsw)), a1 = *(const bf16x8*)(xwt + (pt * 16 + fr) * 72 + ((32 + fq * 8) ^ xsw));
#pragma unroll
            for (int q = 0; q < 4; ++q) { Sacc[q] = Sacc[q] * dec;
                const int bsw = (((((nt0 + q) * 16 + fr) >> 3) & 7) << 3);
                Sacc[q] = mfma16(a0, *(const bf16x8*)(bmt + ((nt0 + q) * 16 + fr) * 72 + ((fq * 8) ^ bsw)), Sacc[q]);
                Sacc[q] = mfma16(a1, *(const bf16x8*)(bmt + ((nt0 + q) * 16 + fr) * 72 + ((32 + fq * 8) ^ bsw)), Sacc[q]); }
        }
        LDSBAR();
    }
#undef SSD_FETCH
    if (wid == 0) atomicAdd(GSS + (size_t)g * NTOK + ((size_t)b * 2048 + 31 * 64) + lane, (u64)((gpart[lane] + gpart[64 + lane]) * FXS));
    float* so = p.out + OO_SSP + ((((size_t)j * 8 + b) * 32 + h) * 64) * 128;
#pragma unroll
    for (int q = 0; q < 4; ++q)
#pragma unroll
        for (int jj = 0; jj < 4; ++jj) so[(size_t)(pt * 16 + fq * 4 + jj) * 128 + (nt0 + q) * 16 + fr] = Sacc[q][jj];
}


__device__ void ssd_sample_loop(KParams& p, int j, int u0, int ustep, unsigned char* shm) {
    const int tid = tid_opaque(), pp = tid & 63, nq = tid >> 6;
    const bf16_t* PROJ = (const bf16_t*)(p.ws + WS_PROJ); const bf16_t* XBC = (const bf16_t*)(p.ws + WS_U); bf16_t* O = (bf16_t*)(p.ws + WS_O);
    const float* DT = (const float*)(p.ws + WS_DT); const float* DA = DT + (size_t)NTOK * 32;
    u64* GSS = (u64*)(p.ws + WS_RSS) + 8 * (size_t)NTOK + (size_t)j * NTOK * 4;
    float* Bs = (float*)shm; float* Cs = Bs + 8 * 128; float* xs = Cs + 8 * 128; float* dts = xs + 8 * 64; float* das = dts + 8; float* yp = das + 8;
    float* stg = (float*)(shm + 32768);
    f32x4 s0[4]; bf16_t bv[2], cv[2], xv, zv; float dtv = 0.f, dav = 0.f;
#define SS_FETCH(uu) do { const int b_ = (uu) >> 5, h_ = (uu) & 31, g_ = h_ >> 3; const size_t base_ = NPR + (size_t)b_ * 8; \
        const float* sp = p.in[I_SSM] + (((size_t)j * 128 + b_) * 32 + h_) * 8192 + tid * 4; \
        _Pragma("unroll") for (int i4 = 0; i4 < 4; ++i4) s0[i4] = *(const f32x4*)(sp + i4 * 2048); \
        _Pragma("unroll") for (int q = 0; q < 2; ++q) { const int idx = tid + q * 512, t = idx >> 7, n = idx & 127; const size_t ro = (base_ + t) * 3072; bv[q] = XBC[ro + 2048 + g_ * 128 + n]; cv[q] = XBC[ro + 2560 + g_ * 128 + n]; } \
        xv = XBC[(base_ + nq) * 3072 + h_ * 64 + pp]; zv = PROJ[(base_ + nq) * 5376 + h_ * 64 + pp]; \
        if (tid < 8) { dtv = DT[(base_ + tid) * 32 + h_]; dav = DA[(base_ + tid) * 32 + h_]; } } while (0)
    if (u0 < 4096) SS_FETCH(u0);
    for (int u = u0; u < 4096; u += ustep) {
        const int b = u >> 5, h = u & 31, g = h >> 3; const size_t base = NPR + (size_t)b * 8;
        const float Dh = p.in[I_SD][j * 32 + h];
        LDSBAR();
#pragma unroll
        for (int i4 = 0; i4 < 4; ++i4) { const int ci = tid + i4 * 512; *(f32x4*)(stg + (ci >> 5) * 132 + (ci & 31) * 4) = s0[i4]; }
#pragma unroll
        for (int q = 0; q < 2; ++q) { Bs[tid + q * 512] = bf2f(bv[q]); Cs[tid + q * 512] = bf2f(cv[q]); }
        xs[tid] = bf2f(xv); const float zc = bf2f(zv);
        if (tid < 8) { dts[tid] = dtv; das[tid] = dav; }
        LDSBAR();
        float S[16];
#pragma unroll
        for (int i4 = 0; i4 < 4; ++i4) { const f32x4 v = *(const f32x4*)(stg + pp * 132 + nq * 16 + i4 * 4); S[i4 * 4] = v[0]; S[i4 * 4 + 1] = v[1]; S[i4 * 4 + 2] = v[2]; S[i4 * 4 + 3] = v[3]; }
        if (u + ustep < 4096) SS_FETCH(u + ustep);
#pragma unroll 2
        for (int t = 0; t < 8; ++t) { const float xdt = xs[t * 64 + pp] * dts[t], da = das[t]; float y = 0.f;
#pragma unroll
            for (int i4 = 0; i4 < 4; ++i4) { const f32x4 b4 = *(const f32x4*)(Bs + t * 128 + nq * 16 + i4 * 4), c4 = *(const f32x4*)(Cs + t * 128 + nq * 16 + i4 * 4);
#pragma unroll
                for (int e = 0; e < 4; ++e) { const int i = i4 * 4 + e; S[i] = da * S[i] + xdt * b4[e]; y += c4[e] * S[i]; } }
            yp[(t * 8 + nq) * 64 + pp] = y; }
        LDSBAR();
        { const int t = nq; const size_t row = base + t; float y = Dh * xs[t * 64 + pp];
#pragma unroll
            for (int q = 0; q < 8; ++q) y += yp[(t * 8 + q) * 64 + pp];
            y *= siluf_(zc);
            O[row * 2048 + h * 64 + pp] = f2bf(y);
            const float ss = wave_sum(y * y);
            if (pp == 0) atomicAdd(GSS + (size_t)g * NTOK + row, (u64)(ss * FXS)); }
#pragma unroll
        for (int i4 = 0; i4 < 4; ++i4) { f32x4 v; v[0] = S[i4 * 4]; v[1] = S[i4 * 4 + 1]; v[2] = S[i4 * 4 + 2]; v[3] = S[i4 * 4 + 3]; *(f32x4*)(stg + pp * 132 + nq * 16 + i4 * 4) = v; }
        LDSBAR();
        float* so = p.out + OO_SSS + (((size_t)j * 128 + b) * 32 + h) * 8192 + tid * 4;
#pragma unroll
        for (int i4 = 0; i4 < 4; ++i4) { const int ci = tid + i4 * 512; *(f32x4*)(so + i4 * 2048) = *(const f32x4*)(stg + (ci >> 5) * 132 + (ci & 31) * 4); }
    }
#undef SS_FETCH
}

__device__ void phase_ssd(KParams& p, int j, unsigned char* shm) {
    const int bid = bid_opaque(), G = gridDim.x;
    const int vb = (G == 256) ? (((bid & 7) * 4 + (bid >> 6)) * 8 + ((bid >> 3) & 7)) : bid;
    for (int u = vb; u < 256; u += G) ssd_prompt_unit(p, j, u >> 5, u & 31, shm);
    ssd_sample_loop(p, j, vb, G, shm);
}
__device__ void phase_gnorm(KParams& p, int j) {
    const bf16_t* O = (const bf16_t*)(p.ws + WS_O); bf16_t* ON = (bf16_t*)(p.ws + WS_ON);
    const u64* GSS = (const u64*)(p.ws + WS_RSS) + 8 * (size_t)NTOK + (size_t)j * NTOK * 4;
    const float* gn = p.in[I_SGN] + (size_t)j * 2048;
    for (int idx = bid_opaque() * 512 + tid_opaque(); idx < NTOK * 256; idx += gridDim.x * 512) {
        const int row = idx >> 8, c8 = (idx & 255) * 8;
        const float r = rsqrtf((float)GSS[(size_t)(c8 >> 9) * NTOK + row] * (FXI / 512.f) + EPSN);
        const u32x4 w = *(const u32x4*)(O + (size_t)row * 2048 + c8); u32x4 o;
#pragma unroll
        for (int q = 0; q < 4; ++q) o[q] = cvt_pk_bf16(bflo(w[q]) * r * gn[c8 + 2 * q], bfhi(w[q]) * r * gn[c8 + 2 * q + 1]);
        *(u32x4*)(ON + (size_t)row * 2048 + c8) = o;
    }
}

__device__ void phase_final(KParams& p) {
    const bf16_t* XH = (const bf16_t*)(p.ws + WS_XN); const u64* RSN = (const u64*)(p.ws + WS_RSS) + RSSN_OFF + 4 * (size_t)NTOK;
    const float* gm = p.in[I_GFIN];
    const int stride = gridDim.x * 512;
    for (int idx0 = bid_opaque() * 512 + tid_opaque(); idx0 < NTOK * 128; idx0 += 2 * stride) { u32x4 xw[2]; float rr[2];
#pragma unroll
        for (int k = 0; k < 2; ++k) { const int idx = idx0 + k * stride; xw[k] = (u32x4){0u, 0u, 0u, 0u}; rr[k] = 0.f;
            if (idx < NTOK * 128) { const int row = idx >> 7, c8 = (idx & 127) * 8; xw[k] = *(const u32x4*)(XH + (size_t)row * 1024 + c8); rr[k] = (float)RSN[row]; } }
#pragma unroll
        for (int k = 0; k < 2; ++k) { const int idx = idx0 + k * stride;
            if (idx < NTOK * 128) { const int row = idx >> 7, c8 = (idx & 127) * 8; const float r = rsqrtf(rr[k] * (FXI / 1024.f) + EPSN);
                const f32x4 g0 = *(const f32x4*)(gm + c8), g1 = *(const f32x4*)(gm + c8 + 4); f32x4 y0, y1;
                y0[0] = bflo(xw[k][0]) * r * g0[0]; y0[1] = bfhi(xw[k][0]) * r * g0[1]; y0[2] = bflo(xw[k][1]) * r * g0[2]; y0[3] = bfhi(xw[k][1]) * r * g0[3];
                y1[0] = bflo(xw[k][2]) * r * g1[0]; y1[1] = bfhi(xw[k][2]) * r * g1[1]; y1[2] = bflo(xw[k][3]) * r * g1[2]; y1[3] = bfhi(xw[k][3]) * r * g1[3];
                *(f32x4*)(p.out + OO_Y + (size_t)row * 1024 + c8) = y0; *(f32x4*)(p.out + OO_Y + (size_t)row * 1024 + c8 + 4) = y1; } }
    }
}

__global__ void __launch_bounds__(512, 2) mega(Params p_) {
    extern __shared__ __attribute__((aligned(16))) unsigned char shm[];
    cg::grid_group grid = cg::this_grid();
    LAS unsigned char* lds = (LAS unsigned char*)shm;
    const int G = gridDim.x;
    unsigned* bar = (unsigned*)(p_.ws + WS_BAR);
    volatile LAS unsigned* st = (volatile LAS unsigned*)(lds + 131072);
    if (threadIdx.x == 0) { st[0] = 0u; st[1] = 0u; st[2] = 0u; st[3] = 0u; }
    if (blockIdx.x == 0) for (int i = threadIdx.x; i < 2 * XCD_BAR_WORDS; i += 512) bar[i] = 0u;
    __syncthreads();
    XcdBarrier xb; xb.bar = bar; xb.x = 0u; xb.st = st; xb.expect = 0u;
    XcdBarrier xb2; xb2.bar = bar + XCD_BAR_WORDS; xb2.x = 0u; xb2.st = st + 2; xb2.expect = 0u;
    const int ph_lo = p_.ph_lo, ph_hi = p_.ph_hi;
    for (int ph = ph_lo; ph < ph_hi; ++ph) {
        const int bid = bid_opaque();
        LAS unsigned char* lds_l = lds; asm volatile("" : "+s"(lds_l));
        unsigned char* shm_l = (unsigned char*)lds_l;
        KParams* kp = (KParams*)__builtin_amdgcn_kernarg_segment_ptr();
        asm volatile("" : "+s"(kp));
        KParams& p = *kp;
        unsigned char* ws = p.ws;
        bf16_t* W = (bf16_t*)(ws + WS_W);
        bf16_t* XH = (bf16_t*)(ws + WS_XN);
        bf16_t* EB = (bf16_t*)(ws + WS_EB); bf16_t* PB = (bf16_t*)(ws + WS_PB);
        bf16_t* PROJ = (bf16_t*)(ws + WS_PROJ); bf16_t* U = (bf16_t*)(ws + WS_U); bf16_t* O = (bf16_t*)(ws + WS_O);
        u64* RSS = (u64*)(ws + WS_RSS);
        if (ph == 0) phase_init(p, shm_l);
        else {
            const int i = (ph - 1) / NPH_PER_LAYER, s = (ph - 1) % NPH_PER_LAYER, j = i >> 1; const bool even = (i & 1) == 0;
            pg8::StaticOrder SO; pg8::Gemm g; g.M = NTOK;
            if (s == 0) {
                const int N = even ? 3072 : 5376;
                g.A = XH; g.Bt = W + (even ? WO_EIN + (size_t)j * 3072 * 1024 : WO_SIN + (size_t)j * 5376 * 1024); g.N = N; g.K = 1024;
                SO.init(NTOK, N, G, bid);
                EpiStore E; E.O = PROJ; E.ldc = N; E.rs0 = RSS + RSSN_OFF + (size_t)i * NTOK;
                pg8::gemm_phase<EpiStore>(lds_l, g, SO, E);
                const int r1 = SO.nwg % G;
                g.A = PB + (size_t)i * NTOK * 256; g.Bt = W + WO_U + (size_t)i * 1024 * 256; g.N = 1024; g.K = 256;
                SO.init(NTOK, 1024, G, (bid - r1 + G) % G);
                E.O = EB; E.ldc = 1024; E.rs0 = nullptr;
                pg8::gemm_phase<EpiStore>(lds_l, g, SO, E);
            } else if (s == 1) {
                if (even) { for (int u = bid; u < 1024; u += G) hgrn_prep_unit(p, j, u, shm_l); phase_conv_lru(p, j); } else phase_conv_ssm(p, j);
            } else if (s == 2) {
                if (even) {
                    if (bid < 32) hgrn_prompt_unit(p, j, bid >> 2, bid & 3, shm_l);
                    else {
                        g.A = U; g.Bt = W + WO_LRU + (size_t)j * 1024 * 512; g.N = 1024; g.K = 512; SO.init(NTOK, 1024, G - 32, bid - 32);
                        EpiLru E; E.LA = (float*)(p.ws + WS_ON); E.LBT = E.LA + (size_t)NTOK * 512; E.U = U; E.ba = p.in[I_LBA] + j * 512; E.bx = p.in[I_LBX] + j * 512; E.lam = p.in[I_LAM] + j * 512;
                        pg8::gemm_phase<EpiLru>(lds_l, g, SO, E);
                        xcd_barrier(xb2);
                        phase_even_scan(p, j, shm_l);
                    }
                } else phase_ssd(p, j, shm_l);
            } else if (s == 3) {
                ;
            } else if (s == 4 || s == 6) {
                EpiResid E; E.XH = XH;
                const u64* gss = nullptr; E.kr = nullptr;
                if (s == 4) { g.A = O; g.K = even ? 1024 : 2048; g.Bt = W + (even ? WO_EOUT + (size_t)j * 1024 * 1024 : WO_SOUT + (size_t)j * 1024 * 2048);
                    E.rss = RSS + (size_t)i * NTOK; }
                else { g.A = PROJ; g.K = 2816; g.Bt = W + WO_2 + (size_t)i * 1024 * 2816; E.rss = nullptr; }
                g.N = 1024; g.M = NPR; SO.init(NPR, 1024, G, bid);
                if (s == 4 && !even) {
                    gss = (const u64*)(p.ws + WS_RSS) + 8 * (size_t)NTOK + (size_t)j * NTOK * 4;
                    pg8::Unit u0; LAS float* kr = (LAS float*)(lds_l + KR_OFF);
                    if (SO.next(0, u0) && threadIdx.x < 256) { const size_t row = (size_t)u0.pm * 256 + threadIdx.x; float r[4];
#pragma unroll
                        for (int q = 0; q < 4; ++q) r[q] = rsqrtf((float)gss[(size_t)q * NTOK + row] * (FXI / 512.f) + EPSN);
                        kr[threadIdx.x * 4 + 0] = r[0] / r[1]; kr[threadIdx.x * 4 + 1] = r[1] / r[2]; kr[threadIdx.x * 4 + 2] = r[2] / r[3]; kr[threadIdx.x * 4 + 3] = r[3]; }
                    __syncthreads();
                    E.kr = kr;
                }
                pg8::gemm_phase<EpiResid>(lds_l, g, SO, E);
                { EpiSResid ES; ES.XH = XH; ES.rss = E.rss;
                  for (int tile = bid; tile < 256; tile += G) sample_gemm<EpiSResid>(shm_l, g.A + (size_t)NPR * g.K, g.Bt, g.K, tile, ES, gss); }
            } else if (s == 5) {
                g.A = XH; g.Bt = W + WO_13 + (size_t)i * 5632 * 1024; g.N = 5632; g.K = 1024; SO.init(NTOK, 5632, G, bid);
                EpiSwiglu E; E.ACT = PROJ; E.rss = RSS + (size_t)i * NTOK;
                pg8::gemm_phase<EpiSwiglu>(lds_l, g, SO, E);
            } else if (s == 7) {
                g.A = XH; g.Bt = W + WO_G + (size_t)i * 1024 * 1024; g.N = 1024; g.K = 1024; g.M = NPR; SO.init(NPR, 1024, G, bid);
                EpiPle E; E.XH = XH; E.EB = EB; E.rss = RSS + (size_t)(4 + i) * NTOK; E.rsn = RSS + RSSN_OFF + (size_t)(i + 1) * NTOK; E.gp = p.in[I_GPLE] + (size_t)i * 1024;
                E.cnt = (unsigned*)(RSS + CNT_OFF) + i * 128;
                pg8::gemm_phase<EpiPle>(lds_l, g, SO, E);
                { EpiSPle ES; ES.XH = XH; ES.EB = EB; ES.rss = E.rss; ES.rsn = E.rsn; ES.gp = E.gp; ES.cnt = E.cnt;
                  for (int tile = bid; tile < 256; tile += G) sample_gemm<EpiSPle>(shm_l, g.A + (size_t)NPR * g.K, g.Bt, g.K, tile, ES); }
            } else if (i == 3) phase_final(p);
        }
        if (ph > 0 && ((ph - 1) % NPH_PER_LAYER == 3 || ((ph - 1) % NPH_PER_LAYER == 8 && ph + 1 < NPHASES))) continue;
        if (ph + 1 < ph_hi) { if (ph == ph_lo) { grid.sync(); xb = xcd_barrier_post(bar, st, gridDim.x); if (blockIdx.x >= 32) xb2 = xcd_barrier_post(bar + XCD_BAR_WORDS, st + 2, gridDim.x - 32); } else xcd_barrier(xb); }
    }
}

extern "C" void kernel_launch(void* const* d_in, const int* in_sizes, int n_in, void* d_out, int out_size, void* d_ws, size_t ws_size, hipStream_t stream) {
    static int grid = 0;
    if (grid == 0) {
        if (n_in != N_IN || (size_t)out_size != OO_END || ws_size < WS_END) { fprintf(stderr, "kernel_launch: unexpected shapes: n_in %d out %d ws %zu (need %zu)\n", n_in, out_size, ws_size, (size_t)WS_END); grid = -1; return; }
        int dev = 0, cus = 0, per_cu = 0;
        (void)hipGetDevice(&dev); (void)hipDeviceGetAttribute(&cus, hipDeviceAttributeMultiprocessorCount, dev);
        if (hipFuncSetAttribute((const void*)mega, hipFuncAttributeMaxDynamicSharedMemorySize, LDS_BYTES) != hipSuccess) { fprintf(stderr, "kernel_launch: hipFuncSetAttribute failed\n"); grid = -1; return; }
        if (hipOccupancyMaxActiveBlocksPerMultiprocessor(&per_cu, (const void*)mega, 512, LDS_BYTES) != hipSuccess || per_cu < 1) { fprintf(stderr, "kernel_launch: occupancy query failed (%d)\n", per_cu); (void)hipGetLastError(); per_cu = 1; }
        grid = cus * 1;
    }
    if (grid < 0) return;
    Params P; memset(&P, 0, sizeof(P));
    for (int i = 0; i < N_IN; ++i) P.in[i] = (const float*)d_in[i];
    P.out = (float*)d_out; P.ws = (unsigned char*)d_ws;
    P.ph_lo = 0; P.ph_hi = NPHASES;
    void* args[] = {&P};
    hipError_t e = hipLaunchCooperativeKernel((const void*)mega, dim3(grid), dim3(512), args, LDS_BYTES, stream);
    if (e != hipSuccess) fprintf(stderr, "kernel_launch: cooperative launch failed: %s (grid %d)\n", hipGetErrorString(e), grid);
}
```
